# Optimizing an MI355X kernel written in HIP

```python
import jax, jax.numpy as jnp
from jax import lax
import numpy as np

D_MODEL = 1024
BATCH = 32
SEQ = 256
DEPTH = 2
DEC_BATCH = 8
DEC_SEQ = 2048
PAST_LEN = 256

GRID_W = 64
EPS = 1e-6
M_HEADS = 6
M_HD = 64
M_W = M_HEADS * M_HD
CHUNK = 64
R_HEADS = 6
R_HD = 64
R_W = R_HEADS * R_HD
R_LORA_W = 64
R_LORA_A = 64
RWKV_DECAY_SCALE = 0.6065306597126334
L_BLOCKS = 4
L_BD = 64
L_W = L_BLOCKS * L_BD
CONV_W = 4
LRU_C = 8.0
MIX_W = M_W + R_W + L_W
M_COLS = 5 * M_W + 4 * M_HEADS
R_SHIFT = 3 * R_W + 2 * R_LORA_W + 2 * R_LORA_A
R_COLS = R_SHIFT + R_W
L_COLS = 2 * L_W
IN_COLS = M_COLS + R_COLS + L_COLS

kernel_name = 'hymba_bidir_mlstm_rwkv7_rglru_dit_step'


def rmsnorm(x, g):
    xf = x.astype(jnp.float32)
    return xf * lax.rsqrt(jnp.mean(xf * xf, axis=-1, keepdims=True) + EPS) * g


def head_rmsnorm(h, g):
    B, T = h.shape[0], h.shape[1]
    hn = h * lax.rsqrt(jnp.mean(h * h, axis=-1, keepdims=True) + EPS)
    return hn.reshape(B, T, -1) * g


def seq_shift(u):
    left = jnp.pad(u[:, :-1], ((0, 0), (1, 0), (0, 0)))
    right = jnp.pad(u[:, 1:], ((0, 0), (0, 1), (0, 0)))
    return 0.5 * (left + right)


def grid_shift(u):
    B, T, C = u.shape
    rows = T // GRID_W
    g = u.reshape(B, rows, GRID_W, C)
    up = jnp.pad(g[:, :-1], ((0, 0), (1, 0), (0, 0), (0, 0)))
    down = jnp.pad(g[:, 1:], ((0, 0), (0, 1), (0, 0), (0, 0)))
    left = jnp.pad(g[:, :, :-1], ((0, 0), (0, 0), (1, 0), (0, 0)))
    right = jnp.pad(g[:, :, 1:], ((0, 0), (0, 0), (0, 1), (0, 0)))
    return (0.25 * (up + down + left + right)).reshape(B, T, C)


def mlstm_chunkwise(q, k, v, i_pre, logf, C0, n0, m0):
    B, H, T, Dh = q.shape
    nc = T // CHUNK
    to_c = lambda t: jnp.moveaxis(t.reshape(B, H, nc, CHUNK, *t.shape[3:]), 2, 0)
    mask = jnp.tril(jnp.ones((CHUNK, CHUNK), dtype=bool))

    def step(carry, inp):
        C, n, m = carry
        qc, kc, vc, ic, fc = inp
        b = jnp.cumsum(fc, axis=-1)
        dmat = jnp.where(mask, b[..., :, None] - b[..., None, :] + ic[..., None, :], -jnp.inf)
        inter = b + m[..., None]
        m_t = jnp.maximum(inter, jnp.max(dmat, axis=-1))
        s = jnp.einsum('bhtd,bhsd->bhts', qc, kc) * jnp.exp(dmat - m_t[..., None])
        sc = jnp.exp(inter - m_t)
        num = sc[..., None] * jnp.einsum('bhtd,bhde->bhte', qc, C) + jnp.einsum('bhts,bhse->bhte', s, vc)
        den = sc * jnp.einsum('bhtd,bhd->bht', qc, n) + jnp.sum(s, axis=-1)
        h = num / jnp.maximum(jnp.abs(den), jnp.exp(-m_t))[..., None]
        bL = b[..., -1]
        g = bL[..., None] - b + ic
        m_new = jnp.maximum(bL + m, jnp.max(g, axis=-1))
        dec = jnp.exp(bL + m - m_new)
        wk = jnp.exp(g - m_new[..., None])
        C_new = dec[..., None, None] * C + jnp.einsum('bhs,bhsd,bhse->bhde', wk, kc, vc)
        n_new = dec[..., None] * n + jnp.einsum('bhs,bhsd->bhd', wk, kc)
        return (C_new, n_new, m_new), h

    (C, n, m), hs = lax.scan(step, (C0, n0, m0), (to_c(q), to_c(k), to_c(v), to_c(i_pre), to_c(logf)))
    return jnp.moveaxis(hs, 0, 2).reshape(B, H, T, Dh), (C, n, m)


def mlstm_branch(u_m, b_i, b_f, norm_g, C0, n0, m0):
    B, T, _ = u_m.shape
    q, k, v, o, z, ig, fg = jnp.split(u_m, [M_W, 2 * M_W, 3 * M_W, 4 * M_W, 5 * M_W, 5 * M_W + 2 * M_HEADS], axis=-1)
    heads = lambda t: t.reshape(B, T, M_HEADS, M_HD).transpose(0, 2, 1, 3)
    q, k, v = heads(q), heads(k) * (M_HD ** -0.5), heads(v)
    ig = (ig.reshape(B, T, 2, M_HEADS) + b_i).transpose(0, 2, 3, 1)
    lf = jax.nn.log_sigmoid(fg.reshape(B, T, 2, M_HEADS) + b_f).transpose(0, 2, 3, 1)
    h_f, (Cf, nf, mf) = mlstm_chunkwise(q, k, v, ig[:, 0], lf[:, 0], C0[:, 0], n0[:, 0], m0[:, 0])
    flip = lambda t: jnp.flip(t, axis=2)
    h_b, (Cb, nb, mb) = mlstm_chunkwise(flip(q), flip(k), flip(v), jnp.flip(ig[:, 1], axis=-1),
                                        jnp.flip(lf[:, 1], axis=-1), C0[:, 1], n0[:, 1], m0[:, 1])
    h = (h_f + flip(h_b)).transpose(0, 2, 1, 3)
    y = head_rmsnorm(h, norm_g) * jax.nn.sigmoid(o) * jax.nn.silu(z)
    return y, (jnp.stack([Cf, Cb], 1), jnp.stack([nf, nb], 1), jnp.stack([mf, mb], 1))


def rwkv_step(S, inp):
    r, w, kh, b, kt, v = inp
    Sk = jnp.einsum('bhvk,bhk->bhv', S, kh)
    S = S * w[:, :, None, :] - Sk[..., None] * b[:, :, None, :] + v[..., None] * kt[:, :, None, :]
    return S, jnp.einsum('bhvk,bhk->bhv', S, r)


def rwkv_branch(u_rs, u_rz, lp, S0, shift_fn):
    B, T, _ = u_rs.shape
    blk = u_rs + lp['r_mu'] * (shift_fn(u_rs) - u_rs)
    r, k, v, wl, al = jnp.split(blk, [R_W, 2 * R_W, 3 * R_W, 3 * R_W + 2 * R_LORA_W], axis=-1)
    wl = wl.reshape(B, T, 2, R_LORA_W)
    al = al.reshape(B, T, 2, R_LORA_A)
    log_w = -RWKV_DECAY_SCALE * jax.nn.sigmoid(lp['r_w0'] + jnp.einsum('btdr,drc->btdc', jnp.tanh(wl), lp['r_w2']))
    a = jax.nn.sigmoid(lp['r_a0'] + jnp.einsum('btdr,drc->btdc', al, lp['r_a2']))
    kappa = (k * lp['r_kk']).reshape(B, T, R_HEADS, R_HD)
    kh = (kappa / jnp.maximum(jnp.sqrt(jnp.sum(kappa * kappa, axis=-1, keepdims=True)), 1e-12)).reshape(B, T, R_W)
    kt = k[:, :, None, :] * (1.0 + (a - 1.0) * lp['r_ka'])
    bvec = kh[:, :, None, :] * a
    tm = lambda t: t.reshape(B, T, R_HEADS, R_HD).transpose(1, 0, 2, 3)
    r_t, kh_t, v_t = tm(r), tm(kh), tm(v)
    ys, finals = [], []
    for d in range(2):
        Sd, yd = lax.scan(rwkv_step, S0[:, d],
                          (r_t, jnp.exp(tm(log_w[:, :, d])), kh_t, tm(bvec[:, :, d]), tm(kt[:, :, d]), v_t),
                          reverse=(d == 1))
        ys.append(yd)
        finals.append(Sd)
    y = (ys[0] + ys[1]).transpose(1, 0, 2, 3)
    bonus = jnp.sum((r * k * lp['r_rk']).reshape(B, T, R_HEADS, R_HD), axis=-1, keepdims=True) * v.reshape(B, T, R_HEADS, R_HD)
    out = head_rmsnorm(y, lp['r_norm']) + bonus.reshape(B, T, R_W)
    return out * jax.nn.silu(u_rz), jnp.stack(finals, 1)


def lru_combine(e1, e2):
    a1, b1 = e1
    a2, b2 = e2
    return a1 * a2, a2 * b1 + b2


def rglru_branch(u_l, lp, h0):
    B, T, _ = u_l.shape
    xl, z = jnp.split(u_l, [L_W], axis=-1)
    xp = jnp.pad(xl, ((0, 0), (CONV_W // 2, CONV_W - 1 - CONV_W // 2), (0, 0)))
    xc = sum(xp[:, j:j + T] * lp['l_conv'][j] for j in range(CONV_W)) + lp['l_conv_b']
    xb = xc.reshape(B, T, L_BLOCKS, L_BD)
    hs, finals = [], []
    for d in range(2):
        rg = jax.nn.sigmoid(jnp.einsum('btni,nio->btno', xb, lp['l_wa'][d]).reshape(B, T, L_W) + lp['l_ba'][d])
        ig = jax.nn.sigmoid(jnp.einsum('btni,nio->btno', xb, lp['l_wx'][d]).reshape(B, T, L_W) + lp['l_bx'][d])
        log_a = -LRU_C * rg * jax.nn.softplus(-lp['l_lambda'][d])
        a = jnp.exp(log_a)
        bt = jnp.sqrt(-jnp.expm1(2.0 * log_a)) * ig * xc
        pos = 0 if d == 0 else T - 1
        bt = bt.at[:, pos].add(a[:, pos] * h0[:, d])
        _, h = lax.associative_scan(lru_combine, (a, bt), reverse=(d == 1), axis=1)
        hs.append(h)
        finals.append(h[:, -1] if d == 0 else h[:, 0])
    return (hs[0] + hs[1]) * jax.nn.silu(z), jnp.stack(finals, 1)


def trunk_layer(x, shift, scale, gate, lp, states, shift_fn):
    h = rmsnorm(x, lp['g_pre']) * (1.0 + scale) + shift
    u = jnp.einsum('btd,dc->btc', h, lp['w_in']).astype(jnp.float32)
    u_m, u_rs, u_rz, u_l = jnp.split(u, [M_COLS, M_COLS + R_SHIFT, M_COLS + R_COLS], axis=-1)
    mC, mn, mm, rS, lh = states
    y_m, (mC2, mn2, mm2) = mlstm_branch(u_m, lp['m_bi'], lp['m_bf'], lp['m_norm'], mC, mn, mm)
    y_r, rS2 = rwkv_branch(u_rs, u_rz, lp, rS, shift_fn)
    y_l, lh2 = rglru_branch(u_l, lp, lh)
    mixed = jnp.concatenate([y_m, y_r, y_l], axis=-1)
    o = jnp.einsum('btc,cd->btd', mixed, lp['w_out'])
    return x + gate * rmsnorm(o, lp['g_post']), (mC2, mn2, mm2, rS2, lh2)


def setup_inputs(seed: int = 0) -> dict:
    key = jax.random.key(seed)
    ks = iter(jax.random.split(key, 48))
    nrm = lambda shape, s: jax.random.normal(next(ks), shape, jnp.float32) * s
    D = D_MODEL
    a_init = jax.random.uniform(next(ks), (DEPTH, 2, L_W), jnp.float32, 0.9, 0.999)
    s_init = a_init ** (1.0 / LRU_C)
    return {
        'x_prompt': nrm((BATCH, SEQ, D), 1.0),
        'x_sample': nrm((DEC_BATCH, DEC_SEQ, D), 1.0),
        'c': nrm((DEC_BATCH, D), 1.0),
        'state_mlstm_C': nrm((DEC_BATCH, DEPTH, 2, M_HEADS, M_HD, M_HD), 0.1),
        'state_mlstm_n': nrm((DEC_BATCH, DEPTH, 2, M_HEADS, M_HD), 0.1),
        'state_mlstm_m': nrm((DEC_BATCH, DEPTH, 2, M_HEADS), 0.5),
        'state_rwkv': nrm((DEC_BATCH, DEPTH, 2, R_HEADS, R_HD, R_HD), 0.1),
        'state_rglru': nrm((DEC_BATCH, DEPTH, 2, L_W), 0.5),
        'c_ctx': nrm((D,), 1.0),
        'g_pre': 1.0 + nrm((DEPTH, D), 0.02),
        'g_post': 1.0 + nrm((DEPTH, D), 0.02),
        'w_mod': nrm((DEPTH, D, 3 * D), 0.5 * D ** -0.5),
        'b_mod': nrm((DEPTH, 3 * D), 0.02),
        'w_in': nrm((DEPTH, D, IN_COLS), D ** -0.5),
        'w_out': nrm((DEPTH, MIX_W, D), MIX_W ** -0.5),
        'm_bi': nrm((DEPTH, 2, M_HEADS), 0.1),
        'm_bf': 3.0 + 3.0 * jax.random.uniform(next(ks), (DEPTH, 2, M_HEADS), jnp.float32),
        'm_norm': 1.0 + nrm((DEPTH, M_W), 0.02),
        'r_mu': jax.random.uniform(next(ks), (DEPTH, R_SHIFT), jnp.float32),
        'r_w0': nrm((DEPTH, 2, R_W), 0.5),
        'r_w2': nrm((DEPTH, 2, R_LORA_W, R_W), 0.5 * R_LORA_W ** -0.5),
        'r_a0': nrm((DEPTH, 2, R_W), 0.1),
        'r_a2': nrm((DEPTH, 2, R_LORA_A, R_W), 0.5 * R_LORA_A ** -0.5),
        'r_kk': 0.85 + nrm((DEPTH, R_W), 0.05),
        'r_ka': 1.0 + nrm((DEPTH, R_W), 0.05),
        'r_rk': nrm((DEPTH, R_W), 0.1),
        'r_norm': 1.0 + nrm((DEPTH, R_W), 0.02),
        'l_conv': nrm((DEPTH, CONV_W, L_W), CONV_W ** -0.5),
        'l_conv_b': nrm((DEPTH, L_W), 0.02),
        'l_wa': nrm((DEPTH, 2, L_BLOCKS, L_BD, L_BD), L_BD ** -0.5),
        'l_ba': nrm((DEPTH, 2, L_W), 0.02),
        'l_wx': nrm((DEPTH, 2, L_BLOCKS, L_BD, L_BD), L_BD ** -0.5),
        'l_bx': nrm((DEPTH, 2, L_W), 0.02),
        'l_lambda': jnp.log(s_init) - jnp.log1p(-s_init),
    }


def reference(x_prompt, x_sample, c, state_mlstm_C, state_mlstm_n, state_mlstm_m, state_rwkv, state_rglru,
              c_ctx, g_pre, g_post, w_mod, b_mod, w_in, w_out, m_bi, m_bf, m_norm, r_mu, r_w0, r_w2, r_a0,
              r_a2, r_kk, r_ka, r_rk, r_norm, l_conv, l_conv_b, l_wa, l_ba, l_wx, l_bx, l_lambda):
    f32 = jnp.float32
    Bp = x_prompt.shape[0]
    zero_states = (jnp.zeros((Bp, 2, M_HEADS, M_HD, M_HD), f32), jnp.zeros((Bp, 2, M_HEADS, M_HD), f32),
                   jnp.zeros((Bp, 2, M_HEADS), f32), jnp.zeros((Bp, 2, R_HEADS, R_HD, R_HD), f32),
                   jnp.zeros((Bp, 2, L_W), f32))
    xp, xs = x_prompt, x_sample
    mC_l, mn_l, mm_l, rS_l, lh_l = [], [], [], [], []
    for l in range(DEPTH):
        lp = dict(g_pre=g_pre[l], g_post=g_post[l], w_in=w_in[l], w_out=w_out[l], m_bi=m_bi[l], m_bf=m_bf[l],
                  m_norm=m_norm[l], r_mu=r_mu[l], r_w0=r_w0[l], r_w2=r_w2[l], r_a0=r_a0[l], r_a2=r_a2[l],
                  r_kk=r_kk[l], r_ka=r_ka[l], r_rk=r_rk[l], r_norm=r_norm[l], l_conv=l_conv[l],
                  l_conv_b=l_conv_b[l], l_wa=l_wa[l], l_ba=l_ba[l], l_wx=l_wx[l], l_bx=l_bx[l],
                  l_lambda=l_lambda[l])
        sh_c, sc_c, gt_c = jnp.split(jax.nn.silu(c_ctx) @ w_mod[l] + b_mod[l], 3, axis=-1)
        xp, st = trunk_layer(xp, sh_c, sc_c, gt_c, lp, zero_states, seq_shift)
        mC_l.append(st[0]); mn_l.append(st[1]); mm_l.append(st[2]); rS_l.append(st[3]); lh_l.append(st[4])
        sh_s, sc_s, gt_s = jnp.split(jax.nn.silu(c) @ w_mod[l] + b_mod[l], 3, axis=-1)
        cache = (state_mlstm_C[:, l].astype(f32), state_mlstm_n[:, l].astype(f32), state_mlstm_m[:, l].astype(f32),
                 state_rwkv[:, l].astype(f32), state_rglru[:, l].astype(f32))
        xs, _ = trunk_layer(xs, sh_s[:, None, :], sc_s[:, None, :], gt_s[:, None, :], lp, cache, grid_shift)
    y_prompt, y_sample = xp, xs
    new_mlstm_C = jnp.stack(mC_l, axis=1)
    new_mlstm_n = jnp.stack(mn_l, axis=1)
    new_mlstm_m = jnp.stack(mm_l, axis=1)
    new_rwkv = jnp.stack(rS_l, axis=1)
    new_rglru = jnp.stack(lh_l, axis=1)
    return (y_prompt, y_sample, new_mlstm_C, new_mlstm_n, new_mlstm_m, new_rwkv, new_rglru)
```

```cpp
#include <hip/hip_runtime.h>
#include <hip/hip_cooperative_groups.h>
#include <cstdio>
namespace cg = cooperative_groups;

#ifndef COOP
#define COOP 1
#endif

typedef __attribute__((ext_vector_type(8))) short bf16x8;
typedef __attribute__((ext_vector_type(4))) float f32x4;
typedef unsigned short bfu;

#define NTOK 24576
#define NTP 8192
#define DM 1024
#define UC 4248
#define EPSF 1e-6f
#define UM_Q 0
#define UM_K 384
#define UM_V 768
#define UM_O 1152
#define UM_Z 1536
#define UM_I 1920
#define UM_F 1932
#define UR 1944
#define URZ 3352
#define UL 3736
#define ULZ 3992

#define OUT_Y 0
#define OUT_C 25165824
#define OUT_N 28311552
#define OUT_M 28360704
#define OUT_R 28361472
#define OUT_L 31507200

#define WS_U 0ull
#define WS_HM 208797696ull
#define WS_MOD 259129344ull
#define WS_CTR 259350528ull
#define WS_WF 259350784ull
#define WS_LF 259744000ull
#define WS_END 260006144ull

#ifndef PHM
#define PHM 127
#endif
#define LDS_BYTES 114688
#define NTHREADS 512

extern __shared__ __attribute__((aligned(16))) unsigned char lds_raw[];
#define SMEM ((float*)lds_raw)

struct Params {
  const float *x_prompt, *x_sample, *c, *sC, *sn, *sm, *sR, *sL, *c_ctx, *g_pre, *g_post, *w_mod, *b_mod, *w_in, *w_out,
      *m_bi, *m_bf, *m_norm, *r_mu, *r_w0, *r_w2, *r_a0, *r_a2, *r_kk, *r_ka, *r_rk, *r_norm, *l_conv, *l_conv_b, *l_wa,
      *l_ba, *l_wx, *l_bx, *l_lambda;
  float* out;
  bfu* U;
  bfu* HM;
  float* MOD;
  unsigned int* ctr;
  bfu* WF;
  bfu* LF;
  long long ph_lo, ph_hi;
};

__device__ __forceinline__ int opaque_tid(int wv) {
  int ln = __builtin_amdgcn_mbcnt_hi(~0u, __builtin_amdgcn_mbcnt_lo(~0u, 0u));
  asm volatile("" : "+v"(ln));
  return wv * 64 + ln;
}
__device__ __forceinline__ bfu f2bf(float f) {
  unsigned u = __float_as_uint(f);
  u += 0x7fffu + ((u >> 16) & 1u);
  return (bfu)(u >> 16);
}
__device__ __forceinline__ float bf2f(bfu h) { return __uint_as_float(((unsigned)h) << 16); }
__device__ __forceinline__ unsigned pack2(float a, float b) { return (unsigned)f2bf(a) | ((unsigned)f2bf(b) << 16); }
__device__ __forceinline__ float sigm(float x) { return 1.f / (1.f + __expf(-x)); }
__device__ __forceinline__ float siluf(float x) { return x / (1.f + __expf(-x)); }
__device__ __forceinline__ void unpack8(uint4 v, float* f) {
  f[0] = __uint_as_float(v.x << 16); f[1] = __uint_as_float(v.x & 0xffff0000u);
  f[2] = __uint_as_float(v.y << 16); f[3] = __uint_as_float(v.y & 0xffff0000u);
  f[4] = __uint_as_float(v.z << 16); f[5] = __uint_as_float(v.z & 0xffff0000u);
  f[6] = __uint_as_float(v.w << 16); f[7] = __uint_as_float(v.w & 0xffff0000u);
}
__device__ __forceinline__ void ld8(const bfu* p, float* f) { unpack8(*(const uint4*)p, f); }
__device__ __forceinline__ void ld8acc(const bfu* p, float* f) {
  float t[8]; unpack8(*(const uint4*)p, t);
#pragma unroll
  for (int j = 0; j < 8; ++j) f[j] += t[j];
}
__device__ __forceinline__ uint4 pack8(const float* f) {
  uint4 v; v.x = pack2(f[0], f[1]); v.y = pack2(f[2], f[3]); v.z = pack2(f[4], f[5]); v.w = pack2(f[6], f[7]);
  return v;
}
__device__ __forceinline__ void load_shift8(const bfu* Ub, int t, int T, int path, const float* mu, float* blk) {
  float u[8], sh[8];
  ld8(Ub + (size_t)t * UC, u);
#pragma unroll
  for (int j = 0; j < 8; ++j) sh[j] = 0.f;
  float cf;
  if (path == 0) {
    if (t > 0) ld8acc(Ub + (size_t)(t - 1) * UC, sh);
    if (t < T - 1) ld8acc(Ub + (size_t)(t + 1) * UC, sh);
    cf = 0.5f;
  } else {
    if (t >= 64) ld8acc(Ub + (size_t)(t - 64) * UC, sh);
    if (t < T - 64) ld8acc(Ub + (size_t)(t + 64) * UC, sh);
    if ((t & 63) > 0) ld8acc(Ub + (size_t)(t - 1) * UC, sh);
    if ((t & 63) < 63) ld8acc(Ub + (size_t)(t + 1) * UC, sh);
    cf = 0.25f;
  }
#pragma unroll
  for (int j = 0; j < 8; ++j) blk[j] = u[j] + mu[j] * (sh[j] * cf - u[j]);
}

__device__ void phase_mod(const Params& p, int wv) {
  float* smem = SMEM;
  const int tid = opaque_tid(wv);
  if (blockIdx.x == 0 && tid < 8) p.ctr[tid] = 0u;
  for (int idx = blockIdx.x * NTHREADS + tid; idx < 24576 + 16384; idx += gridDim.x * NTHREADS) {
    float f[8];
    if (idx < 24576) {
      const int ln = idx & 63, fr = (idx >> 6) & 7, mat = (idx >> 9) & 1, hd = idx >> 10;
      const int h = hd % 6, ld = hd / 6, nt = fr >> 1, ks = fr & 1;
      const float* src = mat ? p.r_a2 : p.r_w2;
#pragma unroll
      for (int j = 0; j < 8; ++j) f[j] = src[((size_t)ld * 64 + 8 * (ln >> 4) + j + 32 * ks) * 384 + h * 64 + nt * 16 + (ln & 15)];
      *(uint4*)(p.WF + (size_t)idx * 8) = pack8(f);
    } else {
      const int id2 = idx - 24576;
      const int ln = id2 & 63, fr = (id2 >> 6) & 7, mat = (id2 >> 9) & 1, ldn = id2 >> 10;
      const int nt = fr >> 1, ks = fr & 1;
      const float* src = mat ? p.l_wx : p.l_wa;
#pragma unroll
      for (int j = 0; j < 8; ++j) f[j] = src[((size_t)ldn * 64 + 8 * (ln >> 4) + j + 32 * ks) * 64 + nt * 16 + (ln & 15)];
      *(uint4*)(p.LF + (size_t)id2 * 8) = pack8(f);
    }
  }
  for (int i = tid; i < 9 * 1024; i += NTHREADS) {
    int v = i >> 10, k = i & 1023;
    float cv = (v == 0) ? p.c_ctx[k] : p.c[(v - 1) * 1024 + k];
    smem[i] = siluf(cv);
  }
  __syncthreads();
  float* red = smem + 9 * 1024;
  const int col = tid & 31, kg = tid >> 5;
  for (int chunk = blockIdx.x; chunk < 192; chunk += gridDim.x) {
    const int l = chunk / 96, n0 = (chunk % 96) * 32;
    const float* w = p.w_mod + (size_t)l * 1024 * 3072 + n0 + col;
    float acc[9];
#pragma unroll
    for (int v = 0; v < 9; ++v) acc[v] = 0.f;
    for (int k = kg * 64; k < kg * 64 + 64; ++k) {
      float wv = w[(size_t)k * 3072];
#pragma unroll
      for (int v = 0; v < 9; ++v) acc[v] += smem[v * 1024 + k] * wv;
    }
#pragma unroll
    for (int v = 0; v < 9; ++v) red[(kg * 9 + v) * 32 + col] = acc[v];
    __syncthreads();
    if (tid < 288) {
      int v = tid >> 5;
      float s = 0.f;
      for (int g = 0; g < 16; ++g) s += red[(g * 9 + v) * 32 + col];
      p.MOD[(size_t)(l * 9 + v) * 3072 + n0 + col] = s + p.b_mod[l * 3072 + n0 + col];
    }
    __syncthreads();
  }
}

__device__ __forceinline__ int modvec(int row) { return row < NTP ? 0 : 1 + ((row - NTP) >> 11); }

__device__ void phase_h0(const Params& p, int wv) {
  const int tid = opaque_tid(wv);
  const int wave = tid >> 6, lane = tid & 63;
  for (int row = blockIdx.x * 8 + wave; row < NTOK; row += gridDim.x * 8) {
    const float* xr = row < NTP ? p.x_prompt + (size_t)row * DM : p.x_sample + (size_t)(row - NTP) * DM;
    float4 v[4];
    float ss = 0.f;
#pragma unroll
    for (int j = 0; j < 4; ++j) {
      v[j] = ((const float4*)xr)[lane + 64 * j];
      ss += v[j].x * v[j].x + v[j].y * v[j].y + v[j].z * v[j].z + v[j].w * v[j].w;
    }
#pragma unroll
    for (int o = 1; o < 64; o <<= 1) ss += __shfl_xor(ss, o);
    const float rstd = rsqrtf(ss * (1.f / 1024.f) + EPSF);
    const float* md = p.MOD + (size_t)modvec(row) * 3072;
#pragma unroll
    for (int j = 0; j < 4; ++j) {
      const int k = (lane + 64 * j) * 4;
      float4 g = *(const float4*)(p.g_pre + k);
      float4 sh = *(const float4*)(md + k);
      float4 sc = *(const float4*)(md + 1024 + k);
      uint2 o;
      o.x = pack2(v[j].x * rstd * g.x * (1.f + sc.x) + sh.x, v[j].y * rstd * g.y * (1.f + sc.y) + sh.y);
      o.y = pack2(v[j].z * rstd * g.z * (1.f + sc.z) + sh.z, v[j].w * rstd * g.w * (1.f + sc.w) + sh.w);
      *(uint2*)(p.HM + (size_t)row * DM + k) = o;
    }
  }
}

#define LDK 40
__device__ __forceinline__ int ldsrow(int n) { return (n & ~63) | ((n & 3) << 4) | ((n >> 2) & 15); }

template <int BM, int BN, int WM, int WN, bool PREF>
__device__ __forceinline__ void gemm_mainloop(const bfu* __restrict__ A, const float* __restrict__ B, int ldb, int n0,
                                              int nvalid, bfu* As, bfu* Bs, f32x4 (&acc)[BM / WM / 16][BN / WN / 16], const int tid) {
  constexpr int TM = BM / WM / 16, TN = BN / WN / 16;
  constexpr int NA = (BM * 4 + NTHREADS - 1) / NTHREADS;
  constexpr int NB = BN * 4 / NTHREADS;
  constexpr int NBH = PREF ? NB : 2;
  const int wave = tid >> 6, lane = tid & 63;
  const int wm = wave / WN, wn = wave % WN;
  const int mbase = wm * (BM / WM), nbase = wn * (BN / WN);
#pragma unroll
  for (int i = 0; i < TM; ++i)
#pragma unroll
    for (int j = 0; j < TN; ++j) acc[i][j] = (f32x4){0.f, 0.f, 0.f, 0.f};

  const __amdgpu_buffer_rsrc_t rsrc = __builtin_amdgcn_make_buffer_rsrc((void*)B, 0, 1024 * ldb * 4, 0x00020000);
  uint4 ra[NA];
  float rb[NBH][8];
#pragma unroll
  for (int j = 0; j < NA; ++j) ra[j] = make_uint4(0u, 0u, 0u, 0u);

#define G_LOADA(ks_)                                                                                        \
  _Pragma("unroll") for (int j = 0; j < NA; ++j) {                                                          \
    const int c = tid + NTHREADS * j;                                                                       \
    if (c < BM * 4) ra[j] = *(const uint4*)(A + (size_t)(c >> 2) * DM + (ks_) * 32 + (c & 3) * 8);          \
  }
#define G_STOREA()                                                                                          \
  _Pragma("unroll") for (int j = 0; j < NA; ++j) {                                                          \
    const int c = tid + NTHREADS * j;                                                                       \
    if (c < BM * 4) *(uint4*)(As + (c >> 2) * LDK + (c & 3) * 8) = ra[j];                                   \
  }
#define G_LOADB(ks_, j0_)                                                                                   \
  _Pragma("unroll") for (int j = 0; j < NBH; ++j) {                                                         \
    const int u = tid + NTHREADS * (j + (j0_));                                                             \
    const int n = u % BN, kg = u / BN;                                                                      \
    const unsigned voff = (n < nvalid) ? (unsigned)((kg * 8 * ldb + n0 + n) * 4) : 0x80000000u;             \
    _Pragma("unroll") for (int jj = 0; jj < 8; ++jj) rb[j][jj] = __builtin_bit_cast(                        \
        float, __builtin_amdgcn_raw_buffer_load_b32(rsrc, voff, (unsigned)(((ks_) * 32 + jj) * ldb * 4), 0)); \
  }
#define G_STOREB(j0_)                                                                                       \
  _Pragma("unroll") for (int j = 0; j < NBH; ++j) {                                                         \
    const int u = tid + NTHREADS * (j + (j0_));                                                             \
    const int n = u % BN, kg = u / BN;                                                                      \
    uint4 pk;                                                                                               \
    pk.x = pack2(rb[j][0], rb[j][1]); pk.y = pack2(rb[j][2], rb[j][3]);                                     \
    pk.z = pack2(rb[j][4], rb[j][5]); pk.w = pack2(rb[j][6], rb[j][7]);                                     \
    *(uint4*)(Bs + ldsrow(n) * LDK + kg * 8) = pk;                                                          \
  }

  if (PREF) {
    G_LOADA(0)
    G_LOADB(0, 0)
  }
#pragma unroll 1
  for (int ks = 0; ks < 32; ++ks) {
    if (PREF) {
      G_STOREA()
      G_STOREB(0)
    } else {
      G_LOADA(ks)
      G_STOREA()
#pragma unroll 1
      for (int j0 = 0; j0 < NB; j0 += NBH) {
        G_LOADB(ks, j0)
        G_STOREB(j0)
      }
    }
    __syncthreads();
    if (PREF && ks + 1 < 32) {
      G_LOADA(ks + 1)
      G_LOADB(ks + 1, 0)
    }
    bf16x8 af[TM];
#pragma unroll
    for (int i = 0; i < TM; ++i) af[i] = *(const bf16x8*)(As + (mbase + i * 16 + (lane & 15)) * LDK + (lane >> 4) * 8);
#pragma unroll
    for (int j = 0; j < TN; ++j) {
      const bf16x8 bfr = *(const bf16x8*)(Bs + (nbase + j * 16 + (lane & 15)) * LDK + (lane >> 4) * 8);
#pragma unroll
      for (int i = 0; i < TM; ++i) acc[i][j] = __builtin_amdgcn_mfma_f32_16x16x32_bf16(af[i], bfr, acc[i][j], 0, 0, 0);
    }
    __syncthreads();
  }
#undef G_LOADA
#undef G_STOREA
#undef G_LOADB
#undef G_STOREB
}

__device__ void phase_inproj(const Params& p, int l, int wv) {
  float* smem = SMEM;
  bfu* As = (bfu*)smem;
  bfu* Bs = As + 256 * LDK;
  const int tid = opaque_tid(wv);
  const int wave = tid >> 6, lane = tid & 63;
  const int wm = wave >> 2, wn = wave & 3;
  for (int tile = blockIdx.x; tile < 96 * 17; tile += gridDim.x) {
    const int m0 = (tile / 17) * 256, n0 = (tile % 17) * 256;
    const int nvalid = min(256, UC - n0);
    f32x4 acc[8][4];
    gemm_mainloop<256, 256, 2, 4, true>(p.HM + (size_t)m0 * DM, p.w_in + (size_t)l * DM * UC, UC, n0, nvalid, As, Bs, acc, tid);
    const int slot = lane & 15, g4 = lane >> 4;
    const int c = n0 + wn * 64 + 4 * slot;
    if (c < UC) {
#pragma unroll
      for (int mt = 0; mt < 8; ++mt)
#pragma unroll
        for (int i = 0; i < 4; ++i) {
          const int row = m0 + wm * 128 + mt * 16 + 4 * g4 + i;
          uint2 o;
          o.x = pack2(acc[mt][0][i], acc[mt][1][i]);
          o.y = pack2(acc[mt][2][i], acc[mt][3][i]);
          *(uint2*)(p.U + (size_t)row * UC + c) = o;
        }
    }
  }
}

__device__ void phase_outproj(const Params& p, int l, int wv) {
  float* smem = SMEM;
  bfu* As = (bfu*)smem;
  bfu* Bs = As + 32 * LDK;
  float* red = (float*)(Bs + 1024 * LDK);
  float* rs = red + 256;
  const int tid = opaque_tid(wv);
  const int wave = tid >> 6, lane = tid & 63;
  const int slot = lane & 15, g4 = lane >> 4;
  for (int tile = blockIdx.x; tile < NTOK / 32; tile += gridDim.x) {
    const int m0 = tile * 32;
    f32x4 acc[2][8];
    gemm_mainloop<32, 1024, 1, 8, true>(p.HM + (size_t)m0 * DM, p.w_out + (size_t)l * DM * DM, DM, 0, DM, As, Bs, acc, tid);
#pragma unroll
    for (int mt = 0; mt < 2; ++mt)
#pragma unroll
      for (int i = 0; i < 4; ++i) {
        float s = 0.f;
#pragma unroll
        for (int nt = 0; nt < 8; ++nt) s += acc[mt][nt][i] * acc[mt][nt][i];
        s += __shfl_xor(s, 1); s += __shfl_xor(s, 2); s += __shfl_xor(s, 4); s += __shfl_xor(s, 8);
        if (slot == 0) red[wave * 32 + mt * 16 + 4 * g4 + i] = s;
      }
    __syncthreads();
    if (tid < 32) {
      float s = 0.f;
      for (int w = 0; w < 8; ++w) s += red[w * 32 + tid];
      rs[tid] = rsqrtf(s * (1.f / 1024.f) + EPSF);
    }
    __syncthreads();
    const int vec = modvec(m0);
    const float* md = p.MOD + (size_t)(l * 9 + vec) * 3072;
#pragma unroll
    for (int mt = 0; mt < 2; ++mt)
#pragma unroll
      for (int i = 0; i < 4; ++i) {
        const int rl = mt * 16 + 4 * g4 + i;
        const int row = m0 + rl;
        const float rstd = rs[rl];
        const float* xin = (l == 0) ? (row < NTP ? p.x_prompt + (size_t)row * DM : p.x_sample + (size_t)(row - NTP) * DM)
                                    : p.out + OUT_Y + (size_t)row * DM;
#pragma unroll
        for (int q = 0; q < 2; ++q) {
          const int c = wave * 128 + 64 * q + 4 * slot;
          float4 xi = *(const float4*)(xin + c);
          float4 gt = *(const float4*)(md + 2048 + c);
          float4 gp = *(const float4*)(p.g_post + l * DM + c);
          float4 xn;
          xn.x = xi.x + gt.x * (acc[mt][4 * q + 0][i] * rstd * gp.x);
          xn.y = xi.y + gt.y * (acc[mt][4 * q + 1][i] * rstd * gp.y);
          xn.z = xi.z + gt.z * (acc[mt][4 * q + 2][i] * rstd * gp.z);
          xn.w = xi.w + gt.w * (acc[mt][4 * q + 3][i] * rstd * gp.w);
          *(float4*)(p.out + OUT_Y + (size_t)row * DM + c) = xn;
          acc[mt][4 * q + 0][i] = xn.x; acc[mt][4 * q + 1][i] = xn.y; acc[mt][4 * q + 2][i] = xn.z; acc[mt][4 * q + 3][i] = xn.w;
        }
        __builtin_amdgcn_sched_barrier(0);
      }
    if (l == 0) {
      __syncthreads();
#pragma unroll
      for (int mt = 0; mt < 2; ++mt)
#pragma unroll
        for (int i = 0; i < 4; ++i) {
          float s = 0.f;
#pragma unroll
          for (int nt = 0; nt < 8; ++nt) s += acc[mt][nt][i] * acc[mt][nt][i];
          s += __shfl_xor(s, 1); s += __shfl_xor(s, 2); s += __shfl_xor(s, 4); s += __shfl_xor(s, 8);
          if (slot == 0) red[wave * 32 + mt * 16 + 4 * g4 + i] = s;
        }
      __syncthreads();
      if (tid < 32) {
        float s = 0.f;
        for (int w = 0; w < 8; ++w) s += red[w * 32 + tid];
        rs[tid] = rsqrtf(s * (1.f / 1024.f) + EPSF);
      }
      __syncthreads();
      const float* md1 = p.MOD + (size_t)(9 + vec) * 3072;
#pragma unroll
      for (int mt = 0; mt < 2; ++mt)
#pragma unroll
        for (int i = 0; i < 4; ++i) {
          const int rl = mt * 16 + 4 * g4 + i;
          const int row = m0 + rl;
          const float rstd = rs[rl];
#pragma unroll
          for (int q = 0; q < 2; ++q) {
            const int c = wave * 128 + 64 * q + 4 * slot;
            float4 g = *(const float4*)(p.g_pre + DM + c);
            float4 sh = *(const float4*)(md1 + c);
            float4 sc = *(const float4*)(md1 + 1024 + c);
            uint2 o;
            o.x = pack2(acc[mt][4 * q + 0][i] * rstd * g.x * (1.f + sc.x) + sh.x, acc[mt][4 * q + 1][i] * rstd * g.y * (1.f + sc.y) + sh.y);
            o.y = pack2(acc[mt][4 * q + 2][i] * rstd * g.z * (1.f + sc.z) + sh.z, acc[mt][4 * q + 3][i] * rstd * g.w * (1.f + sc.w) + sh.w);
            *(uint2*)(p.HM + (size_t)row * DM + c) = o;
          }
          __builtin_amdgcn_sched_barrier(0);
        }
    }
    __syncthreads();
  }
}

__device__ void rwkv_job(const Params& p, int l, int path, int ubase, int wv) {
  float* smem = SMEM;
  const int tid = opaque_tid(wv);
  const int wave = tid >> 6, lane = tid & 63;
  const bool active = wave < 4;
  const int dir = wave & 1;
  const int unit = ubase + ((wave >> 1) & 1);
  const int b = unit / 6, h = unit % 6;
  const int T = path ? 2048 : 256, NT = T >> 4;
  const size_t tok0 = path ? (size_t)NTP + (size_t)b * 2048 : (size_t)b * 256;
  const bfu* Ub = p.U + tok0 * UC;
  bfu* Mb = p.HM + tok0 * DM + 384 + h * 64;
  float* L = smem + (wave & 3) * 6848;
  float* PRM = L + 6144;
  float *LR = L, *LV = L + 1024, *LKH = L + 2048, *LW = L + 3072, *LB = L + 4096, *LKT = L + 5120;
  float S[64];
  const bf16x8* wf = (const bf16x8*)p.WF + ((size_t)((l * 2 + dir) * 6 + h) * 16) * 64 + lane;
  const int tl = lane >> 2, c0 = (lane & 3) * 16;
  const int slot = lane & 15, g4 = lane >> 4;
  if (active) {
    {
      const float* mu0 = p.r_mu + l * 1408;
      PRM[lane] = mu0[h * 64 + lane];
      PRM[64 + lane] = mu0[384 + h * 64 + lane];
      PRM[128 + lane] = mu0[768 + h * 64 + lane];
      PRM[192 + lane] = mu0[1152 + dir * 64 + lane];
      PRM[256 + lane] = mu0[1280 + dir * 64 + lane];
      PRM[320 + lane] = p.r_rk[l * 384 + h * 64 + lane];
      PRM[384 + lane] = p.r_kk[l * 384 + h * 64 + lane];
      PRM[448 + lane] = p.r_ka[l * 384 + h * 64 + lane];
      PRM[512 + lane] = p.r_norm[l * 384 + h * 64 + lane];
      PRM[576 + lane] = p.r_w0[(l * 2 + dir) * 384 + h * 64 + lane];
      PRM[640 + lane] = p.r_a0[(l * 2 + dir) * 384 + h * 64 + lane];
    }
    if (path) {
      const float* sp = p.sR + ((((size_t)(b * 2 + l) * 2 + dir) * 6 + h) * 64 + lane) * 64;
#pragma unroll
      for (int k4 = 0; k4 < 16; ++k4) {
        float4 v = ((const float4*)sp)[k4];
        S[4 * k4] = v.x; S[4 * k4 + 1] = v.y; S[4 * k4 + 2] = v.z; S[4 * k4 + 3] = v.w;
      }
    } else {
#pragma unroll
      for (int k = 0; k < 64; ++k) S[k] = 0.f;
    }
  }
  __syncthreads();
#pragma unroll 1
  for (int it = 0; it < NT; ++it) {
    const int ti = dir ? NT - 1 - it : it;
    const int t0 = ti * 16;
    float bon = 0.f;
    if (active) {
      {
        const int t = t0 + tl;
        float part = 0.f;
#pragma unroll
        for (int hh = 0; hh < 2; ++hh) {
          const int cc = h * 64 + c0 + hh * 8;
          const int cl = c0 + hh * 8;
          float rr[8], kk[8], vv[8];
          load_shift8(Ub + UR + cc, t, T, path, PRM + cl, rr);
          __builtin_amdgcn_sched_barrier(0);
          load_shift8(Ub + UR + 384 + cc, t, T, path, PRM + 64 + cl, kk);
          __builtin_amdgcn_sched_barrier(0);
          load_shift8(Ub + UR + 768 + cc, t, T, path, PRM + 128 + cl, vv);
          __builtin_amdgcn_sched_barrier(0);
#pragma unroll
          for (int j = 0; j < 8; ++j) {
            LR[tl * 64 + c0 + hh * 8 + j] = rr[j];
            LV[tl * 64 + c0 + hh * 8 + j] = vv[j];
            LKH[tl * 64 + c0 + hh * 8 + j] = kk[j];
            part += rr[j] * kk[j] * PRM[320 + cl + j];
          }
          __builtin_amdgcn_sched_barrier(0);
        }
        part += __shfl_xor(part, 1);
        part += __shfl_xor(part, 2);
        bon = part;
      }
      {
        const int t = t0 + slot;
        bf16x8 awl[2], aal[2];
#pragma unroll
        for (int ks = 0; ks < 2; ++ks) {
          float blk[8];
          const int cw = 1152 + dir * 64 + 32 * ks + 8 * g4;
          load_shift8(Ub + UR + cw, t, T, path, PRM + 192 + 32 * ks + 8 * g4, blk);
#pragma unroll
          for (int j = 0; j < 8; ++j) awl[ks][j] = (short)f2bf(tanhf(blk[j]));
          const int ca = 1280 + dir * 64 + 32 * ks + 8 * g4;
          load_shift8(Ub + UR + ca, t, T, path, PRM + 256 + 32 * ks + 8 * g4, blk);
#pragma unroll
          for (int j = 0; j < 8; ++j) aal[ks][j] = (short)f2bf(blk[j]);
        }
#pragma unroll
        for (int nt = 0; nt < 4; ++nt) {
          f32x4 aw = {0.f, 0.f, 0.f, 0.f}, aa = {0.f, 0.f, 0.f, 0.f};
#pragma unroll
          for (int ks = 0; ks < 2; ++ks) {
            aw = __builtin_amdgcn_mfma_f32_16x16x32_bf16(awl[ks], wf[(nt * 2 + ks) * 64], aw, 0, 0, 0);
            aa = __builtin_amdgcn_mfma_f32_16x16x32_bf16(aal[ks], wf[(8 + nt * 2 + ks) * 64], aa, 0, 0, 0);
          }
          const int col = nt * 16 + slot;
          const float w0v = PRM[576 + col];
          const float a0v = PRM[640 + col];
#pragma unroll
          for (int i = 0; i < 4; ++i) {
            const int tt = 4 * g4 + i;
            LW[tt * 64 + col] = __expf(-0.6065306597126334f * sigm(w0v + aw[i]));
            LB[tt * 64 + col] = sigm(a0v + aa[i]);
          }
        }
      }
    }
    __syncthreads();
    if (active) {
      float kap[16], kr[16], av[16];
      float ss = 0.f;
#pragma unroll
      for (int j = 0; j < 16; ++j) {
        kr[j] = LKH[tl * 64 + c0 + j];
        av[j] = LB[tl * 64 + c0 + j];
        kap[j] = kr[j] * PRM[384 + c0 + j];
        ss += kap[j] * kap[j];
      }
      ss += __shfl_xor(ss, 1);
      ss += __shfl_xor(ss, 2);
      const float inv = 1.f / fmaxf(sqrtf(ss), 1e-12f);
#pragma unroll
      for (int j = 0; j < 16; ++j) {
        const float kh = kap[j] * inv;
        LKH[tl * 64 + c0 + j] = kh;
        LKT[tl * 64 + c0 + j] = kr[j] * (1.f + (av[j] - 1.f) * PRM[448 + c0 + j]);
        LB[tl * 64 + c0 + j] = kh * av[j];
      }
    }
    __syncthreads();
    if (active) {
#pragma unroll 1
      for (int s_ = 0; s_ < 16; ++s_) {
        const int s = dir ? 15 - s_ : s_;
        const float4* kh4 = (const float4*)(LKH + s * 64);
        const float4* w4 = (const float4*)(LW + s * 64);
        const float4* b4 = (const float4*)(LB + s * 64);
        const float4* kt4 = (const float4*)(LKT + s * 64);
        const float4* r4 = (const float4*)(LR + s * 64);
        float sk0 = 0.f, sk1 = 0.f, sk2 = 0.f, sk3 = 0.f;
#pragma unroll
        for (int k4 = 0; k4 < 16; ++k4) {
          float4 x = kh4[k4];
          sk0 += S[4 * k4] * x.x; sk1 += S[4 * k4 + 1] * x.y; sk2 += S[4 * k4 + 2] * x.z; sk3 += S[4 * k4 + 3] * x.w;
          if ((k4 & 7) == 7) __builtin_amdgcn_sched_barrier(0);
        }
        const float sk = (sk0 + sk1) + (sk2 + sk3);
        const float vv = LV[s * 64 + lane];
        float y0 = 0.f, y1 = 0.f, y2 = 0.f, y3 = 0.f;
#pragma unroll
        for (int k4 = 0; k4 < 16; ++k4) {
          float4 w = w4[k4], bb = b4[k4], kt = kt4[k4], r = r4[k4];
          S[4 * k4] = S[4 * k4] * w.x + (vv * kt.x - sk * bb.x); y0 += S[4 * k4] * r.x;
          S[4 * k4 + 1] = S[4 * k4 + 1] * w.y + (vv * kt.y - sk * bb.y); y1 += S[4 * k4 + 1] * r.y;
          S[4 * k4 + 2] = S[4 * k4 + 2] * w.z + (vv * kt.z - sk * bb.z); y2 += S[4 * k4 + 2] * r.z;
          S[4 * k4 + 3] = S[4 * k4 + 3] * w.w + (vv * kt.w - sk * bb.w); y3 += S[4 * k4 + 3] * r.w;
          if ((k4 & 3) == 3) __builtin_amdgcn_sched_barrier(0);
        }
        LR[s * 64 + lane] = (y0 + y1) + (y2 + y3);
      }
    }
    __syncthreads();
    if (active) {
      const int t = t0 + tl;
      bfu* mp = Mb + (size_t)t * DM + c0;
      float y[16];
#pragma unroll
      for (int j = 0; j < 16; ++j) y[j] = LR[tl * 64 + c0 + j];
      if (it < NT / 2) {
        *(uint4*)mp = pack8(y);
        *(uint4*)(mp + 8) = pack8(y + 8);
      } else {
        float pp[16], gz[16];
        ld8(mp, pp); ld8(mp + 8, pp + 8);
        const bfu* gp = Ub + (size_t)t * UC + URZ + h * 64 + c0;
        ld8(gp, gz); ld8(gp + 8, gz + 8);
        float ss = 0.f;
#pragma unroll
        for (int j = 0; j < 16; ++j) { y[j] += pp[j]; ss += y[j] * y[j]; }
        ss += __shfl_xor(ss, 1);
        ss += __shfl_xor(ss, 2);
        const float rstd = rsqrtf(ss * (1.f / 64.f) + EPSF);
#pragma unroll
        for (int j = 0; j < 16; ++j) {
          float o = y[j] * rstd * PRM[512 + c0 + j] + bon * LV[tl * 64 + c0 + j];
          y[j] = o * siluf(gz[j]);
        }
        *(uint4*)mp = pack8(y);
        *(uint4*)(mp + 8) = pack8(y + 8);
      }
    }
    __syncthreads();
  }
  if (active && path == 0) {
    float* op = p.out + OUT_R + ((((size_t)(b * 2 + l) * 2 + dir) * 6 + h) * 64 + lane) * 64;
#pragma unroll
    for (int k4 = 0; k4 < 16; ++k4) {
      float4 v; v.x = S[4 * k4]; v.y = S[4 * k4 + 1]; v.z = S[4 * k4 + 2]; v.w = S[4 * k4 + 3];
      ((float4*)op)[k4] = v;
    }
  }
}

#define LS 72
__device__ void mlstm_job(const Params& p, int l, int path, int unit, int wv) {
  float* smem = SMEM;
  const int tid = opaque_tid(wv);
  const int wave = tid >> 6, lane = tid & 63;
  const int dir = wave >> 2, w = wave & 3, tg = tid & 255;
  const int b = unit / 6, h = unit % 6;
  const int T = path ? 2048 : 256, NC = T >> 6;
  const size_t tok0 = path ? (size_t)NTP + (size_t)b * 2048 : (size_t)b * 256;
  const bfu* Ub = p.U + tok0 * UC;
  bfu* Mb = p.HM + tok0 * DM + h * 64;
  bfu* base = (bfu*)smem + dir * (288 * LS);
  bfu *KWT = base, *VT = base + 64 * LS, *CT = base + 144 * LS, *P = base + 224 * LS;
  float* fb = smem + (2 * 288 * LS * 2) / 4 + dir * 272;
  float *X = fb, *MX = fb + 64, *BC = fb + 128, *WK = fb + 192, *SC = fb + 256;
  const int slot = lane & 15, g4 = lane >> 4;
  f32x4 C[5];
  float mstate = 0.f;
#pragma unroll
  for (int nt = 0; nt < 5; ++nt) C[nt] = (f32x4){0.f, 0.f, 0.f, 0.f};
  if (path) {
    const size_t sb = ((size_t)(b * 2 + l) * 2 + dir) * 6 + h;
    mstate = p.sm[sb];
#pragma unroll
    for (int nt = 0; nt < 4; ++nt)
#pragma unroll
      for (int i = 0; i < 4; ++i) C[nt][i] = p.sC[(sb * 64 + 16 * w + 4 * g4 + i) * 64 + nt * 16 + slot];
    if (slot == 0)
#pragma unroll
      for (int i = 0; i < 4; ++i) C[4][i] = p.sn[sb * 64 + 16 * w + 4 * g4 + i];
  }
  for (int i = tg; i < 16 * LS; i += 256) VT[64 * LS + i] = (i < 64) ? (bfu)0x3F80 : (bfu)0;
  const float bi = p.m_bi[l * 12 + dir * 6 + h], bff = p.m_bf[l * 12 + dir * 6 + h];
  __syncthreads();
  for (int ic = 0; ic < NC; ++ic) {
    const int ch = dir ? NC - 1 - ic : ic;
    const int c0t = ch * 64;
    if (w == 0) {
      const bfu* ur = Ub + (size_t)(c0t + lane) * UC;
      const float ip = bf2f(ur[UM_I + dir * 6 + h]) + bi;
      const float fp = bf2f(ur[UM_F + dir * 6 + h]) + bff;
      const float lf = fminf(fp, 0.f) - log1pf(__expf(-fabsf(fp)));
      float bs = lf;
      if (dir == 0) {
#pragma unroll
        for (int o = 1; o < 64; o <<= 1) { float v = __shfl_up(bs, o); if (lane >= o) bs += v; }
      } else {
#pragma unroll
        for (int o = 1; o < 64; o <<= 1) { float v = __shfl_down(bs, o); if (lane + o < 64) bs += v; }
      }
      const float x = ip - bs;
      float pm = x;
      if (dir == 0) {
#pragma unroll
        for (int o = 1; o < 64; o <<= 1) { float v = __shfl_up(pm, o); if (lane >= o) pm = fmaxf(pm, v); }
      } else {
#pragma unroll
        for (int o = 1; o < 64; o <<= 1) { float v = __shfl_down(pm, o); if (lane + o < 64) pm = fmaxf(pm, v); }
      }
      const int last = dir ? 0 : 63;
      const float pmtot = __shfl(pm, last), bL = __shfl(bs, last);
      const float mref = fmaxf(mstate, pmtot);
      X[lane] = x; MX[lane] = fmaxf(mstate, pm); BC[lane] = bs; WK[lane] = __expf(x - mref);
      if (lane == 0) { SC[0] = __expf(mstate - mref); SC[1] = bL + mref; }
    }
#pragma unroll
    for (int nt = 0; nt < 5; ++nt) {
      uint2 o;
      o.x = pack2(C[nt][0], C[nt][1]);
      o.y = pack2(C[nt][2], C[nt][3]);
      *(uint2*)(CT + (nt * 16 + slot) * LS + 16 * w + 4 * g4) = o;
    }
    __syncthreads();
    {
      const int s = tg >> 2, cq = (tg & 3) * 16;
      const bfu* ur = Ub + (size_t)(c0t + s) * UC + h * 64 + cq;
      float kf[16];
      ld8(ur + UM_K, kf); ld8(ur + UM_K + 8, kf + 8);
      const float sc = 0.125f * WK[s];
      const uint4 v0 = *(const uint4*)(ur + UM_V), v1 = *(const uint4*)(ur + UM_V + 8);
      const unsigned vv[8] = {v0.x, v0.y, v0.z, v0.w, v1.x, v1.y, v1.z, v1.w};
#pragma unroll
      for (int j = 0; j < 16; ++j) {
        KWT[(cq + j) * LS + s] = f2bf(kf[j] * sc);
        VT[(cq + j) * LS + s] = (bfu)((j & 1) ? (vv[j >> 1] >> 16) : (vv[j >> 1] & 0xffffu));
      }
    }
    bf16x8 aq[2];
    {
      const bfu* qp = Ub + (size_t)(c0t + 16 * w + slot) * UC + UM_Q + h * 64 + 8 * g4;
      aq[0] = *(const bf16x8*)qp;
      aq[1] = *(const bf16x8*)(qp + 32);
      f32x4 aS[4];
#pragma unroll
      for (int nt = 0; nt < 4; ++nt) {
        const bfu* kp = Ub + (size_t)(c0t + nt * 16 + slot) * UC + UM_K + h * 64 + 8 * g4;
        bf16x8 k0 = *(const bf16x8*)kp, k1 = *(const bf16x8*)(kp + 32);
        aS[nt] = (f32x4){0.f, 0.f, 0.f, 0.f};
        aS[nt] = __builtin_amdgcn_mfma_f32_16x16x32_bf16(aq[0], k0, aS[nt], 0, 0, 0);
        aS[nt] = __builtin_amdgcn_mfma_f32_16x16x32_bf16(aq[1], k1, aS[nt], 0, 0, 0);
      }
#pragma unroll
      for (int i = 0; i < 4; ++i) {
        const int t = 16 * w + 4 * g4 + i;
        const float mxt = MX[t];
#pragma unroll
        for (int nt = 0; nt < 4; ++nt) {
          const int s = nt * 16 + slot;
          const bool keep = dir ? (s >= t) : (s <= t);
          const float pv = keep ? aS[nt][i] * 0.125f * __expf(X[s] - mxt) : 0.f;
          P[t * LS + s] = f2bf(pv);
        }
      }
    }
    __syncthreads();
    f32x4 hv[4];
    {
      bf16x8 ap[2];
      const bfu* pp = P + (16 * w + slot) * LS + 8 * g4;
      ap[0] = *(const bf16x8*)pp; ap[1] = *(const bf16x8*)(pp + 32);
      f32x4 aC[5], aP[5];
#pragma unroll
      for (int nt = 0; nt < 5; ++nt) {
        aC[nt] = (f32x4){0.f, 0.f, 0.f, 0.f};
        aP[nt] = (f32x4){0.f, 0.f, 0.f, 0.f};
#pragma unroll
        for (int ks = 0; ks < 2; ++ks) {
          bf16x8 bc = *(const bf16x8*)(CT + (nt * 16 + slot) * LS + 32 * ks + 8 * g4);
          bf16x8 bv = *(const bf16x8*)(VT + (nt * 16 + slot) * LS + 32 * ks + 8 * g4);
          aC[nt] = __builtin_amdgcn_mfma_f32_16x16x32_bf16(aq[ks], bc, aC[nt], 0, 0, 0);
          aP[nt] = __builtin_amdgcn_mfma_f32_16x16x32_bf16(ap[ks], bv, aP[nt], 0, 0, 0);
        }
      }
#pragma unroll
      for (int i = 0; i < 4; ++i) {
        const int t = 16 * w + 4 * g4 + i;
        const float mxt = MX[t];
        const float sc = __expf(mstate - mxt);
        float den = sc * aC[4][i] + aP[4][i];
        den = __shfl(den, lane & 48);
        const float lower = __expf(-(BC[t] + mxt));
        const float inv = 1.f / fmaxf(fabsf(den), lower);
#pragma unroll
        for (int nt = 0; nt < 4; ++nt) hv[nt][i] = (sc * aC[nt][i] + aP[nt][i]) * inv;
      }
    }
#pragma unroll
    for (int i = 0; i < 4; ++i) {
      const int t = c0t + 16 * w + 4 * g4 + i;
      bfu* mp = Mb + (size_t)t * DM;
      if (ic < NC / 2) {
#pragma unroll
        for (int nt = 0; nt < 4; ++nt) mp[nt * 16 + slot] = f2bf(hv[nt][i]);
      } else {
        float hh[4];
        float ss = 0.f;
#pragma unroll
        for (int nt = 0; nt < 4; ++nt) { hh[nt] = hv[nt][i] + bf2f(mp[nt * 16 + slot]); ss += hh[nt] * hh[nt]; }
        ss += __shfl_xor(ss, 1); ss += __shfl_xor(ss, 2); ss += __shfl_xor(ss, 4); ss += __shfl_xor(ss, 8);
        const float rstd = rsqrtf(ss * (1.f / 64.f) + EPSF);
        const bfu* ur = Ub + (size_t)t * UC + h * 64;
#pragma unroll
        for (int nt = 0; nt < 4; ++nt) {
          const int e = nt * 16 + slot;
          const float o = bf2f(ur[UM_O + e]), z = bf2f(ur[UM_Z + e]);
          mp[e] = f2bf(hh[nt] * rstd * p.m_norm[l * 384 + h * 64 + e] * sigm(o) * siluf(z));
        }
      }
    }
    {
      const float dec = SC[0];
      bf16x8 ak[2];
      const bfu* kp = KWT + (16 * w + slot) * LS + 8 * g4;
      ak[0] = *(const bf16x8*)kp; ak[1] = *(const bf16x8*)(kp + 32);
#pragma unroll
      for (int nt = 0; nt < 5; ++nt) {
        f32x4 aD = {0.f, 0.f, 0.f, 0.f};
#pragma unroll
        for (int ks = 0; ks < 2; ++ks) {
          bf16x8 bv = *(const bf16x8*)(VT + (nt * 16 + slot) * LS + 32 * ks + 8 * g4);
          aD = __builtin_amdgcn_mfma_f32_16x16x32_bf16(ak[ks], bv, aD, 0, 0, 0);
        }
#pragma unroll
        for (int i = 0; i < 4; ++i) C[nt][i] = dec * C[nt][i] + aD[i];
      }
      mstate = SC[1];
    }
    __syncthreads();
  }
  if (path == 0) {
    const size_t sb = ((size_t)(b * 2 + l) * 2 + dir) * 6 + h;
#pragma unroll
    for (int nt = 0; nt < 4; ++nt)
#pragma unroll
      for (int i = 0; i < 4; ++i) p.out[OUT_C + (sb * 64 + 16 * w + 4 * g4 + i) * 64 + nt * 16 + slot] = C[nt][i];
    if (slot == 0)
#pragma unroll
      for (int i = 0; i < 4; ++i) p.out[OUT_N + sb * 64 + 16 * w + 4 * g4 + i] = C[4][i];
    if (tg == 0) p.out[OUT_M + sb] = mstate;
  }
}

__device__ void lru_job(const Params& p, int l, int path, int unit, int wv) {
  float* smem = SMEM;
  const int tid = opaque_tid(wv);
  const int wave = tid >> 6, lane = tid & 63;
  const int dir = wave >> 2, w = wave & 3, tg = tid & 255;
  const int b = unit >> 2, n = unit & 3;
  const int T = path ? 2048 : 256, NT = T >> 6;
  const size_t tok0 = path ? (size_t)NTP + (size_t)b * 2048 : (size_t)b * 256;
  const bfu* Ub = p.U + tok0 * UC;
  bfu* Mb = p.HM + tok0 * DM + 768 + n * 64;
  unsigned char* sb_ = (unsigned char*)smem + dir * 41984;
  bfu* XC = (bfu*)sb_;
  float* AA = (float*)(sb_ + 9216);
  float* BB = AA + 4096;
  const int slot = lane & 15, g4 = lane >> 4;
  const bf16x8* lf = (const bf16x8*)p.LF + ((size_t)((l * 2 + dir) * 4 + n) * 16) * 64 + lane;
  float hstate = 0.f;
  if (path) hstate = p.sL[((size_t)(b * 2 + l) * 2 + dir) * 256 + n * 64 + lane];
  for (int it = 0; it < NT; ++it) {
    const int ti = dir ? NT - 1 - it : it;
    const int t0 = ti * 64;
    const int tl = tg >> 2, cq = (tg & 3) * 16;
    {
      const int t = t0 + tl;
      float acc[16];
#pragma unroll
      for (int j = 0; j < 16; ++j) acc[j] = p.l_conv_b[l * 256 + n * 64 + cq + j];
#pragma unroll
      for (int tap = 0; tap < 4; ++tap) {
        const int ts = t + tap - 2;
        if (ts >= 0 && ts < T) {
          float xv[16];
          const bfu* ur = Ub + (size_t)ts * UC + UL + n * 64 + cq;
          ld8(ur, xv); ld8(ur + 8, xv + 8);
#pragma unroll
          for (int j = 0; j < 16; ++j) acc[j] += xv[j] * p.l_conv[(l * 4 + tap) * 256 + n * 64 + cq + j];
        }
      }
      *(uint4*)(XC + tl * LS + cq) = pack8(acc);
      *(uint4*)(XC + tl * LS + cq + 8) = pack8(acc + 8);
    }
    __syncthreads();
    {
      bf16x8 ax[2];
      const bfu* xp = XC + (16 * w + slot) * LS + 8 * g4;
      ax[0] = *(const bf16x8*)xp; ax[1] = *(const bf16x8*)(xp + 32);
#pragma unroll
      for (int nt = 0; nt < 4; ++nt) {
        f32x4 ga = {0.f, 0.f, 0.f, 0.f}, gx = {0.f, 0.f, 0.f, 0.f};
#pragma unroll
        for (int ks = 0; ks < 2; ++ks) {
          ga = __builtin_amdgcn_mfma_f32_16x16x32_bf16(ax[ks], lf[(nt * 2 + ks) * 64], ga, 0, 0, 0);
          gx = __builtin_amdgcn_mfma_f32_16x16x32_bf16(ax[ks], lf[(8 + nt * 2 + ks) * 64], gx, 0, 0, 0);
        }
        const int o = nt * 16 + slot;
        const int chn = (l * 2 + dir) * 256 + n * 64 + o;
        const float bav = p.l_ba[chn], bxv = p.l_bx[chn];
        const float lam = p.l_lambda[chn];
        const float sp = fmaxf(-lam, 0.f) + log1pf(__expf(-fabsf(lam)));
#pragma unroll
        for (int i = 0; i < 4; ++i) {
          const int t = 16 * w + 4 * g4 + i;
          const float rg = sigm(ga[i] + bav), ig = sigm(gx[i] + bxv);
          const float la = -8.f * rg * sp;
          const float a = __expf(la);
          const float bt = sqrtf(fmaxf(-expm1f(2.f * la), 0.f)) * ig * bf2f(XC[t * LS + o]);
          AA[t * 64 + o] = a;
          BB[t * 64 + o] = bt;
        }
      }
    }
    __syncthreads();
    if (w == 0) {
#pragma unroll 4
      for (int s_ = 0; s_ < 64; ++s_) {
        const int s = dir ? 63 - s_ : s_;
        hstate = AA[s * 64 + lane] * hstate + BB[s * 64 + lane];
        BB[s * 64 + lane] = hstate;
      }
    }
    __syncthreads();
    {
      const int t = t0 + tl;
      bfu* mp = Mb + (size_t)t * DM + cq;
      float y[16];
#pragma unroll
      for (int j = 0; j < 16; ++j) y[j] = BB[tl * 64 + cq + j];
      if (it >= NT / 2) {
        float pp[16], gz[16];
        ld8(mp, pp); ld8(mp + 8, pp + 8);
        const bfu* gp = Ub + (size_t)t * UC + ULZ + n * 64 + cq;
        ld8(gp, gz); ld8(gp + 8, gz + 8);
#pragma unroll
        for (int j = 0; j < 16; ++j) y[j] = (y[j] + pp[j]) * siluf(gz[j]);
      }
      *(uint4*)mp = pack8(y);
      *(uint4*)(mp + 8) = pack8(y + 8);
    }
    __syncthreads();
  }
  if (path == 0 && w == 0) p.out[OUT_L + ((size_t)(b * 2 + l) * 2 + dir) * 256 + n * 64 + lane] = hstate;
}

__device__ void phase_mix(const Params& p, int l, int wv) {
  __shared__ int sjob;
  for (;;) {
    if (wv == 0 && opaque_tid(0) == 0) sjob = (int)atomicAdd(&p.ctr[l], 1u);
    __syncthreads();
    const int job = sjob;
    __syncthreads();
    if (job >= 520) break;
    int type, path, idx;
    if (job < 24) { type = 0; path = 1; idx = job * 2; }
    else if (job < 120) { type = 0; path = 0; idx = (job - 24) * 2; }
    else if (job < 168) { type = 1; path = 1; idx = job - 120; }
    else if (job < 200) { type = 2; path = 1; idx = job - 168; }
    else if (job < 392) { type = 1; path = 0; idx = job - 200; }
    else { type = 2; path = 0; idx = job - 392; }
    if (type == 0) { if (PHM & 16) rwkv_job(p, l, path, idx, wv); }
    else if (type == 1) { if (PHM & 32) mlstm_job(p, l, path, idx, wv); }
    else { if (PHM & 64) lru_job(p, l, path, idx, wv); }
    __syncthreads();
  }
}

template <bool USE_GRID>
__global__ void __launch_bounds__(NTHREADS) mega_kernel(Params p) {
  const int wv = __builtin_amdgcn_readfirstlane((int)(threadIdx.x >> 6));
  const int lo = (int)p.ph_lo, hi = (int)p.ph_hi;
  for (int ph = lo; ph < hi; ++ph) {
    if (ph == 0) { if (PHM & 1) phase_mod(p, wv); }
    else if (ph == 1) { if (PHM & 2) phase_h0(p, wv); }
    else {
      const int l = (ph - 2) / 3, s = (ph - 2) % 3;
      if (s == 0) { if (PHM & 4) phase_inproj(p, l, wv); }
      else if (s == 1) phase_mix(p, l, wv);
      else { if (PHM & 8) phase_outproj(p, l, wv); }
    }
    if constexpr (USE_GRID) {
      if (ph + 1 < hi) cg::this_grid().sync();
    }
  }
}

extern "C" void kernel_launch(void* const* d_in, const int* in_sizes, int n_in, void* d_out, int out_size, void* d_ws,
                              size_t ws_size, hipStream_t stream) {
  static int grid = 0;
  if (grid == 0) {
    if (n_in != 34 || ws_size < WS_END) {
      fprintf(stderr, "kernel_launch: unexpected n_in %d or ws_size %zu (< %llu)\n", n_in, ws_size, WS_END);
      grid = -1;
      return;
    }
    int dev = 0, cus = 0, per_cu = 0;
    hipGetDevice(&dev);
    hipDeviceGetAttribute(&cus, hipDeviceAttributeMultiprocessorCount, dev);
#if COOP
    hipFuncSetAttribute((const void*)mega_kernel<true>, hipFuncAttributeMaxDynamicSharedMemorySize, LDS_BYTES);
    hipOccupancyMaxActiveBlocksPerMultiprocessor(&per_cu, (const void*)mega_kernel<true>, NTHREADS, LDS_BYTES);
#else
    hipFuncSetAttribute((const void*)mega_kernel<false>, hipFuncAttributeMaxDynamicSharedMemorySize, LDS_BYTES);
    hipOccupancyMaxActiveBlocksPerMultiprocessor(&per_cu, (const void*)mega_kernel<false>, NTHREADS, LDS_BYTES);
#endif
    if (per_cu < 1) { fprintf(stderr, "kernel_launch: occupancy query returned %d\n", per_cu); per_cu = 1; }
    if (per_cu > 1) per_cu = 1;
    grid = cus * per_cu;
  }
  if (grid < 0) return;
  Params p{};
  const float** pf = (const float**)&p;
  for (int i = 0; i < 34; ++i) pf[i] = (const float*)d_in[i];
  p.out = (float*)d_out;
  p.U = (bfu*)((char*)d_ws + WS_U);
  p.HM = (bfu*)((char*)d_ws + WS_HM);
  p.MOD = (float*)((char*)d_ws + WS_MOD);
  p.ctr = (unsigned int*)((char*)d_ws + WS_CTR);
  p.WF = (bfu*)((char*)d_ws + WS_WF);
  p.LF = (bfu*)((char*)d_ws + WS_LF);
#if COOP
  p.ph_lo = 0; p.ph_hi = 8;
  void* args[] = {&p};
  hipError_t e = hipLaunchCooperativeKernel((const void*)mega_kernel<true>, dim3(grid), dim3(NTHREADS), args, LDS_BYTES, stream);
  if (e != hipSuccess) fprintf(stderr, "cooperative launch failed: %s (grid %d)\n", hipGetErrorString(e), grid);
#else
  for (int ph = 0; ph < 8; ++ph) {
    p.ph_lo = ph; p.ph_hi = ph + 1;
    hipLaunchKernelGGL(mega_kernel<false>, dim3(grid), dim3(NTHREADS), LDS_BYTES, stream, p);
  }
#endif
}
```

```cpp
#include <hip/hip_runtime.h>
#include <hip/hip_cooperative_groups.h>
#include <cstdio>
namespace cg = cooperative_groups;

#ifndef COOP
#define COOP 1
#endif

typedef __attribute__((ext_vector_type(8))) short bf16x8;
typedef __attribute__((ext_vector_type(4))) float f32x4;
typedef unsigned short bfu;

#define NTOK 24576
#define NTP 8192
#define DM 1024
#define UC 4248
#define EPSF 1e-6f
#define UM_Q 0
#define UM_K 384
#define UM_V 768
#define UM_O 1152
#define UM_Z 1536
#define UM_I 1920
#define UM_F 1932
#define UR 1944
#define URZ 3352
#define UL 3736
#define ULZ 3992

#define OUT_Y 0
#define OUT_C 25165824
#define OUT_N 28311552
#define OUT_M 28360704
#define OUT_R 28361472
#define OUT_L 31507200

#define WS_U 0ull
#define WS_HM 208797696ull
#define WS_MOD 259129344ull
#define WS_CTR 259350528ull
#define WS_WF 259350784ull
#define WS_LF 259744000ull
#define WS_END 260006144ull

#ifndef PHM
#define PHM 127
#endif
#ifndef PROBE_SEL
#define PROBE_SEL 0
#endif
#define PROBE_MULT 4
#define WS_TS 260006144ull
#define LDS_BYTES 114688
#define NTHREADS 512

extern __shared__ __attribute__((aligned(16))) unsigned char lds_raw[];
#define SMEM ((float*)lds_raw)

struct Params {
  const float *x_prompt, *x_sample, *c, *sC, *sn, *sm, *sR, *sL, *c_ctx, *g_pre, *g_post, *w_mod, *b_mod, *w_in, *w_out,
      *m_bi, *m_bf, *m_norm, *r_mu, *r_w0, *r_w2, *r_a0, *r_a2, *r_kk, *r_ka, *r_rk, *r_norm, *l_conv, *l_conv_b, *l_wa,
      *l_ba, *l_wx, *l_bx, *l_lambda;
  float* out;
  bfu* U;
  bfu* HM;
  float* MOD;
  unsigned int* ctr;
  bfu* WF;
  bfu* LF;
  unsigned long long* ts;
  long long ph_lo, ph_hi;
};

__device__ __forceinline__ int opaque_tid(int wv) {
  int ln = __builtin_amdgcn_mbcnt_hi(~0u, __builtin_amdgcn_mbcnt_lo(~0u, 0u));
  asm volatile("" : "+v"(ln));
  return wv * 64 + ln;
}
template <int M>
__device__ __forceinline__ float shx(float v) {
  return __builtin_bit_cast(float, __builtin_amdgcn_ds_swizzle(__builtin_bit_cast(int, v), (M << 10) | 0x1F));
}
__device__ __forceinline__ float bperm(int srclane, float v) {
  return __builtin_bit_cast(float, __builtin_amdgcn_ds_bpermute(srclane << 2, __builtin_bit_cast(int, v)));
}
__device__ __forceinline__ bfu f2bf(float f) {
  unsigned u = __float_as_uint(f);
  u += 0x7fffu + ((u >> 16) & 1u);
  return (bfu)(u >> 16);
}
__device__ __forceinline__ float bf2f(bfu h) { return __uint_as_float(((unsigned)h) << 16); }
__device__ __forceinline__ unsigned pack2(float a, float b) { return (unsigned)f2bf(a) | ((unsigned)f2bf(b) << 16); }
__device__ __forceinline__ float sigm(float x) { return 1.f / (1.f + __expf(-x)); }
__device__ __forceinline__ float siluf(float x) { return x / (1.f + __expf(-x)); }
__device__ __forceinline__ void unpack8(uint4 v, float* f) {
  f[0] = __uint_as_float(v.x << 16); f[1] = __uint_as_float(v.x & 0xffff0000u);
  f[2] = __uint_as_float(v.y << 16); f[3] = __uint_as_float(v.y & 0xffff0000u);
  f[4] = __uint_as_float(v.z << 16); f[5] = __uint_as_float(v.z & 0xffff0000u);
  f[6] = __uint_as_float(v.w << 16); f[7] = __uint_as_float(v.w & 0xffff0000u);
}
__device__ __forceinline__ void ld8(const bfu* p, float* f) { unpack8(*(const uint4*)p, f); }
__device__ __forceinline__ void ld8acc(const bfu* p, float* f) {
  float t[8]; unpack8(*(const uint4*)p, t);
#pragma unroll
  for (int j = 0; j < 8; ++j) f[j] += t[j];
}
__device__ __forceinline__ uint4 pack8(const float* f) {
  uint4 v; v.x = pack2(f[0], f[1]); v.y = pack2(f[2], f[3]); v.z = pack2(f[4], f[5]); v.w = pack2(f[6], f[7]);
  return v;
}
__device__ __forceinline__ void load_shift8(const bfu* Ub, int t, int T, int path, const float* mu, float* blk) {
  float u[8], sh[8];
  ld8(Ub + (size_t)t * UC, u);
#pragma unroll
  for (int j = 0; j < 8; ++j) sh[j] = 0.f;
  float cf;
  if (path == 0) {
    if (t > 0) ld8acc(Ub + (size_t)(t - 1) * UC, sh);
    if (t < T - 1) ld8acc(Ub + (size_t)(t + 1) * UC, sh);
    cf = 0.5f;
  } else {
    if (t >= 64) ld8acc(Ub + (size_t)(t - 64) * UC, sh);
    if (t < T - 64) ld8acc(Ub + (size_t)(t + 64) * UC, sh);
    if ((t & 63) > 0) ld8acc(Ub + (size_t)(t - 1) * UC, sh);
    if ((t & 63) < 63) ld8acc(Ub + (size_t)(t + 1) * UC, sh);
    cf = 0.25f;
  }
#pragma unroll
  for (int j = 0; j < 8; ++j) blk[j] = u[j] + mu[j] * (sh[j] * cf - u[j]);
}

__device__ void phase_mod(const Params& p, int wv) {
  float* smem = SMEM;
  const int tid = opaque_tid(wv);
  if (blockIdx.x == 0 && tid < 8) p.ctr[tid] = 0u;
  if (PROBE_SEL && blockIdx.x == 0 && tid < 64) p.ts[tid] = 0ull;
  for (int idx = blockIdx.x * NTHREADS + tid; idx < 24576 + 16384; idx += gridDim.x * NTHREADS) {
    float f[8];
    if (idx < 24576) {
      const int ln = idx & 63, fr = (idx >> 6) & 7, mat = (idx >> 9) & 1, hd = idx >> 10;
      const int h = hd % 6, ld = hd / 6, nt = fr >> 1, ks = fr & 1;
      const float* src = mat ? p.r_a2 : p.r_w2;
#pragma unroll
      for (int j = 0; j < 8; ++j) f[j] = src[((size_t)ld * 64 + 8 * (ln >> 4) + j + 32 * ks) * 384 + h * 64 + nt * 16 + (ln & 15)];
      *(uint4*)(p.WF + (size_t)idx * 8) = pack8(f);
    } else {
      const int id2 = idx - 24576;
      const int ln = id2 & 63, fr = (id2 >> 6) & 7, mat = (id2 >> 9) & 1, ldn = id2 >> 10;
      const int nt = fr >> 1, ks = fr & 1;
      const float* src = mat ? p.l_wx : p.l_wa;
#pragma unroll
      for (int j = 0; j < 8; ++j) f[j] = src[((size_t)ldn * 64 + 8 * (ln >> 4) + j + 32 * ks) * 64 + nt * 16 + (ln & 15)];
      *(uint4*)(p.LF + (size_t)id2 * 8) = pack8(f);
    }
  }
  for (int i = tid; i < 9 * 1024; i += NTHREADS) {
    int v = i >> 10, k = i & 1023;
    float cv = (v == 0) ? p.c_ctx[k] : p.c[(v - 1) * 1024 + k];
    smem[i] = siluf(cv);
  }
  __syncthreads();
  float* red = smem + 9 * 1024;
  const int col = tid & 31, kg = tid >> 5;
  for (int chunk = blockIdx.x; chunk < 192; chunk += gridDim.x) {
    const int l = chunk / 96, n0 = (chunk % 96) * 32;
    const float* w = p.w_mod + (size_t)l * 1024 * 3072 + n0 + col;
    float acc[9];
#pragma unroll
    for (int v = 0; v < 9; ++v) acc[v] = 0.f;
    for (int k = kg * 64; k < kg * 64 + 64; ++k) {
      float wv = w[(size_t)k * 3072];
#pragma unroll
      for (int v = 0; v < 9; ++v) acc[v] += smem[v * 1024 + k] * wv;
    }
#pragma unroll
    for (int v = 0; v < 9; ++v) red[(kg * 9 + v) * 32 + col] = acc[v];
    __syncthreads();
    if (tid < 288) {
      int v = tid >> 5;
      float s = 0.f;
      for (int g = 0; g < 16; ++g) s += red[(g * 9 + v) * 32 + col];
      p.MOD[(size_t)(l * 9 + v) * 3072 + n0 + col] = s + p.b_mod[l * 3072 + n0 + col];
    }
    __syncthreads();
  }
}

__device__ __forceinline__ int modvec(int row) { return row < NTP ? 0 : 1 + ((row - NTP) >> 11); }

__device__ void phase_h0(const Params& p, int wv) {
  const int tid = opaque_tid(wv);
  const int wave = tid >> 6, lane = tid & 63;
  for (int row = blockIdx.x * 8 + wave; row < NTOK; row += gridDim.x * 8) {
    const float* xr = row < NTP ? p.x_prompt + (size_t)row * DM : p.x_sample + (size_t)(row - NTP) * DM;
    float4 v[4];
    float ss = 0.f;
#pragma unroll
    for (int j = 0; j < 4; ++j) {
      v[j] = ((const float4*)xr)[lane + 64 * j];
      ss += v[j].x * v[j].x + v[j].y * v[j].y + v[j].z * v[j].z + v[j].w * v[j].w;
    }
    ss += shx<1>(ss); ss += shx<2>(ss); ss += shx<4>(ss); ss += shx<8>(ss); ss += shx<16>(ss);
    ss = __builtin_amdgcn_readlane(ss, 0) + __builtin_amdgcn_readlane(ss, 32);
    const float rstd = rsqrtf(ss * (1.f / 1024.f) + EPSF);
    const float* md = p.MOD + (size_t)modvec(row) * 3072;
#pragma unroll
    for (int j = 0; j < 4; ++j) {
      const int k = (lane + 64 * j) * 4;
      float4 g = *(const float4*)(p.g_pre + k);
      float4 sh = *(const float4*)(md + k);
      float4 sc = *(const float4*)(md + 1024 + k);
      uint2 o;
      o.x = pack2(v[j].x * rstd * g.x * (1.f + sc.x) + sh.x, v[j].y * rstd * g.y * (1.f + sc.y) + sh.y);
      o.y = pack2(v[j].z * rstd * g.z * (1.f + sc.z) + sh.z, v[j].w * rstd * g.w * (1.f + sc.w) + sh.w);
      *(uint2*)(p.HM + (size_t)row * DM + k) = o;
    }
  }
}

#define LDK 40
__device__ __forceinline__ int ldsrow(int n) { return (n & ~63) | ((n & 3) << 4) | ((n >> 2) & 15); }

template <int BM, int BN, int WM, int WN, bool PREF>
__device__ __forceinline__ void gemm_mainloop(const bfu* __restrict__ A, const float* __restrict__ B, int ldb, int n0,
                                              int nvalid, bfu* As, bfu* Bs, f32x4 (&acc)[BM / WM / 16][BN / WN / 16], const int tid) {
  constexpr int TM = BM / WM / 16, TN = BN / WN / 16;
  constexpr int NA = (BM * 4 + NTHREADS - 1) / NTHREADS;
  constexpr int NB = BN * 4 / NTHREADS;
  constexpr int NBH = PREF ? NB : 2;
  const int wave = tid >> 6, lane = tid & 63;
  const int wm = wave / WN, wn = wave % WN;
  const int mbase = wm * (BM / WM), nbase = wn * (BN / WN);
#pragma unroll
  for (int i = 0; i < TM; ++i)
#pragma unroll
    for (int j = 0; j < TN; ++j) acc[i][j] = (f32x4){0.f, 0.f, 0.f, 0.f};

  const __amdgpu_buffer_rsrc_t rsrc = __builtin_amdgcn_make_buffer_rsrc((void*)B, 0, 1024 * ldb * 4, 0x00020000);
  uint4 ra[NA];
  float rb[NBH][8];
#pragma unroll
  for (int j = 0; j < NA; ++j) ra[j] = make_uint4(0u, 0u, 0u, 0u);

#define G_LOADA(ks_)                                                                                        \
  _Pragma("unroll") for (int j = 0; j < NA; ++j) {                                                          \
    const int c = tid + NTHREADS * j;                                                                       \
    if (c < BM * 4) ra[j] = *(const uint4*)(A + (size_t)(c >> 2) * DM + (ks_) * 32 + (c & 3) * 8);          \
  }
#define G_STOREA()                                                                                          \
  _Pragma("unroll") for (int j = 0; j < NA; ++j) {                                                          \
    const int c = tid + NTHREADS * j;                                                                       \
    if (c < BM * 4) *(uint4*)(As + (c >> 2) * LDK + (c & 3) * 8) = ra[j];                                   \
  }
#define G_LOADB(ks_, j0_)                                                                                   \
  _Pragma("unroll") for (int j = 0; j < NBH; ++j) {                                                         \
    const int u = tid + NTHREADS * (j + (j0_));                                                             \
    const int n = u % BN, kg = u / BN;                                                                      \
    const unsigned voff = (n < nvalid) ? (unsigned)((kg * 8 * ldb + n0 + n) * 4) : 0x80000000u;             \
    _Pragma("unroll") for (int jj = 0; jj < 8; ++jj) rb[j][jj] = __builtin_bit_cast(                        \
        float, __builtin_amdgcn_raw_buffer_load_b32(rsrc, voff, (unsigned)(((ks_) * 32 + jj) * ldb * 4), 0)); \
  }
#define G_STOREB(j0_)                                                                                       \
  _Pragma("unroll") for (int j = 0; j < NBH; ++j) {                                                         \
    const int u = tid + NTHREADS * (j + (j0_));                                                             \
    const int n = u % BN, kg = u / BN;                                                                      \
    uint4 pk;                                                                                               \
    pk.x = pack2(rb[j][0], rb[j][1]); pk.y = pack2(rb[j][2], rb[j][3]);                                     \
    pk.z = pack2(rb[j][4], rb[j][5]); pk.w = pack2(rb[j][6], rb[j][7]);                                     \
    *(uint4*)(Bs + ldsrow(n) * LDK + kg * 8) = pk;                                                          \
  }

  if (PREF) {
    G_LOADA(0)
    G_LOADB(0, 0)
  }
#pragma unroll 1
  for (int ks = 0; ks < 32; ++ks) {
    if (PREF) {
      G_STOREA()
      G_STOREB(0)
    } else {
      G_LOADA(ks)
      G_STOREA()
#pragma unroll 1
      for (int j0 = 0; j0 < NB; j0 += NBH) {
        G_LOADB(ks, j0)
        G_STOREB(j0)
      }
    }
    __syncthreads();
    if (PREF && ks + 1 < 32) {
      G_LOADA(ks + 1)
      G_LOADB(ks + 1, 0)
    }
    bf16x8 af[TM];
#pragma unroll
    for (int i = 0; i < TM; ++i) af[i] = *(const bf16x8*)(As + (mbase + i * 16 + (lane & 15)) * LDK + (lane >> 4) * 8);
#pragma unroll
    for (int j = 0; j < TN; ++j) {
      const bf16x8 bfr = *(const bf16x8*)(Bs + (nbase + j * 16 + (lane & 15)) * LDK + (lane >> 4) * 8);
#pragma unroll
      for (int i = 0; i < TM; ++i) acc[i][j] = __builtin_amdgcn_mfma_f32_16x16x32_bf16(af[i], bfr, acc[i][j], 0, 0, 0);
    }
    __syncthreads();
  }
#undef G_LOADA
#undef G_STOREA
#undef G_LOADB
#undef G_STOREB
}

__device__ void phase_inproj(const Params& p, int l, int wv) {
  float* smem = SMEM;
  bfu* As = (bfu*)smem;
  bfu* Bs = As + 256 * LDK;
  const int tid = opaque_tid(wv);
  const int wave = tid >> 6, lane = tid & 63;
  const int wm = wave >> 2, wn = wave & 3;
  for (int tile = blockIdx.x; tile < 96 * 17; tile += gridDim.x) {
    const int m0 = (tile / 17) * 256, n0 = (tile % 17) * 256;
    const int nvalid = min(256, UC - n0);
    f32x4 acc[8][4];
    gemm_mainloop<256, 256, 2, 4, true>(p.HM + (size_t)m0 * DM, p.w_in + (size_t)l * DM * UC, UC, n0, nvalid, As, Bs, acc, tid);
    const int slot = lane & 15, g4 = lane >> 4;
    const int c = n0 + wn * 64 + 4 * slot;
    if (c < UC) {
#pragma unroll
      for (int mt = 0; mt < 8; ++mt)
#pragma unroll
        for (int i = 0; i < 4; ++i) {
          const int row = m0 + wm * 128 + mt * 16 + 4 * g4 + i;
          uint2 o;
          o.x = pack2(acc[mt][0][i], acc[mt][1][i]);
          o.y = pack2(acc[mt][2][i], acc[mt][3][i]);
          *(uint2*)(p.U + (size_t)row * UC + c) = o;
        }
    }
  }
}

__device__ void phase_outproj(const Params& p, int l, int wv) {
  float* smem = SMEM;
  bfu* As = (bfu*)smem;
  bfu* Bs = As + 32 * LDK;
  float* red = (float*)(Bs + 1024 * LDK);
  float* rs = red + 256;
  const int tid = opaque_tid(wv);
  const int wave = tid >> 6, lane = tid & 63;
  const int slot = lane & 15, g4 = lane >> 4;
  for (int tile = blockIdx.x; tile < NTOK / 32; tile += gridDim.x) {
    const int m0 = tile * 32;
    f32x4 acc[2][8];
    gemm_mainloop<32, 1024, 1, 8, true>(p.HM + (size_t)m0 * DM, p.w_out + (size_t)l * DM * DM, DM, 0, DM, As, Bs, acc, tid);
#pragma unroll
    for (int mt = 0; mt < 2; ++mt)
#pragma unroll
      for (int i = 0; i < 4; ++i) {
        float s = 0.f;
#pragma unroll
        for (int nt = 0; nt < 8; ++nt) s += acc[mt][nt][i] * acc[mt][nt][i];
        s += shx<1>(s); s += shx<2>(s); s += shx<4>(s); s += shx<8>(s);
        if (slot == 0) red[wave * 32 + mt * 16 + 4 * g4 + i] = s;
      }
    __syncthreads();
    if (tid < 32) {
      float s = 0.f;
      for (int w = 0; w < 8; ++w) s += red[w * 32 + tid];
      rs[tid] = rsqrtf(s * (1.f / 1024.f) + EPSF);
    }
    __syncthreads();
    const int vec = modvec(m0);
    const float* md = p.MOD + (size_t)(l * 9 + vec) * 3072;
#pragma unroll
    for (int mt = 0; mt < 2; ++mt)
#pragma unroll
      for (int i = 0; i < 4; ++i) {
        const int rl = mt * 16 + 4 * g4 + i;
        const int row = m0 + rl;
        const float rstd = rs[rl];
        const float* xin = (l == 0) ? (row < NTP ? p.x_prompt + (size_t)row * DM : p.x_sample + (size_t)(row - NTP) * DM)
                                    : p.out + OUT_Y + (size_t)row * DM;
#pragma unroll
        for (int q = 0; q < 2; ++q) {
          const int c = wave * 128 + 64 * q + 4 * slot;
          float4 xi = *(const float4*)(xin + c);
          float4 gt = *(const float4*)(md + 2048 + c);
          float4 gp = *(const float4*)(p.g_post + l * DM + c);
          float4 xn;
          xn.x = xi.x + gt.x * (acc[mt][4 * q + 0][i] * rstd * gp.x);
          xn.y = xi.y + gt.y * (acc[mt][4 * q + 1][i] * rstd * gp.y);
          xn.z = xi.z + gt.z * (acc[mt][4 * q + 2][i] * rstd * gp.z);
          xn.w = xi.w + gt.w * (acc[mt][4 * q + 3][i] * rstd * gp.w);
          *(float4*)(p.out + OUT_Y + (size_t)row * DM + c) = xn;
          acc[mt][4 * q + 0][i] = xn.x; acc[mt][4 * q + 1][i] = xn.y; acc[mt][4 * q + 2][i] = xn.z; acc[mt][4 * q + 3][i] = xn.w;
        }
        __builtin_amdgcn_sched_barrier(0);
      }
    if (l == 0) {
      __syncthreads();
#pragma unroll
      for (int mt = 0; mt < 2; ++mt)
#pragma unroll
        for (int i = 0; i < 4; ++i) {
          float s = 0.f;
#pragma unroll
          for (int nt = 0; nt < 8; ++nt) s += acc[mt][nt][i] * acc[mt][nt][i];
          s += shx<1>(s); s += shx<2>(s); s += shx<4>(s); s += shx<8>(s);
          if (slot == 0) red[wave * 32 + mt * 16 + 4 * g4 + i] = s;
        }
      __syncthreads();
      if (tid < 32) {
        float s = 0.f;
        for (int w = 0; w < 8; ++w) s += red[w * 32 + tid];
        rs[tid] = rsqrtf(s * (1.f / 1024.f) + EPSF);
      }
      __syncthreads();
      const float* md1 = p.MOD + (size_t)(9 + vec) * 3072;
#pragma unroll
      for (int mt = 0; mt < 2; ++mt)
#pragma unroll
        for (int i = 0; i < 4; ++i) {
          const int rl = mt * 16 + 4 * g4 + i;
          const int row = m0 + rl;
          const float rstd = rs[rl];
#pragma unroll
          for (int q = 0; q < 2; ++q) {
            const int c = wave * 128 + 64 * q + 4 * slot;
            float4 g = *(const float4*)(p.g_pre + DM + c);
            float4 sh = *(const float4*)(md1 + c);
            float4 sc = *(const float4*)(md1 + 1024 + c);
            uint2 o;
            o.x = pack2(acc[mt][4 * q + 0][i] * rstd * g.x * (1.f + sc.x) + sh.x, acc[mt][4 * q + 1][i] * rstd * g.y * (1.f + sc.y) + sh.y);
            o.y = pack2(acc[mt][4 * q + 2][i] * rstd * g.z * (1.f + sc.z) + sh.z, acc[mt][4 * q + 3][i] * rstd * g.w * (1.f + sc.w) + sh.w);
            *(uint2*)(p.HM + (size_t)row * DM + c) = o;
          }
          __builtin_amdgcn_sched_barrier(0);
        }
    }
    __syncthreads();
  }
}

#define RS 68
#define RBUF (6 * 16 * RS + 16)
typedef float f2v __attribute__((ext_vector_type(2)));
typedef float f4v __attribute__((ext_vector_type(4)));

__device__ __forceinline__ void rwkv_prep_tile(const bfu* Ub, const float* PRM, float* buf, const bf16x8* wf, int t0, int T, int path,
                                               int dir, int h, int lane) {
  float *LR = buf, *LV = buf + 16 * RS, *LKH = buf + 32 * RS, *LW = buf + 48 * RS, *LB = buf + 64 * RS, *LKT = buf + 80 * RS;
  float* BON = buf + 96 * RS;
  const int tl = lane >> 2, c0 = (lane & 3) * 16;
  const int slot = lane & 15, g4 = lane >> 4;
  {
    const int t = t0 + tl;
    float part = 0.f;
#pragma unroll
    for (int hh = 0; hh < 2; ++hh) {
      const int cl = c0 + hh * 8;
      float rr[8], kk[8], vv[8];
      load_shift8(Ub + UR + h * 64 + cl, t, T, path, PRM + cl, rr);
      load_shift8(Ub + UR + 384 + h * 64 + cl, t, T, path, PRM + 64 + cl, kk);
      load_shift8(Ub + UR + 768 + h * 64 + cl, t, T, path, PRM + 128 + cl, vv);
      *(f4v*)(LR + tl * RS + cl) = (f4v){rr[0], rr[1], rr[2], rr[3]};
      *(f4v*)(LR + tl * RS + cl + 4) = (f4v){rr[4], rr[5], rr[6], rr[7]};
      *(f4v*)(LV + tl * RS + cl) = (f4v){vv[0], vv[1], vv[2], vv[3]};
      *(f4v*)(LV + tl * RS + cl + 4) = (f4v){vv[4], vv[5], vv[6], vv[7]};
      *(f4v*)(LKH + tl * RS + cl) = (f4v){kk[0], kk[1], kk[2], kk[3]};
      *(f4v*)(LKH + tl * RS + cl + 4) = (f4v){kk[4], kk[5], kk[6], kk[7]};
#pragma unroll
      for (int j = 0; j < 8; ++j) part += rr[j] * kk[j] * PRM[320 + cl + j];
    }
    part += shx<1>(part);
    part += shx<2>(part);
    BON[tl] = part;
  }
  {
    const int t = t0 + slot;
    bf16x8 awl[2], aal[2];
#pragma unroll
    for (int ks = 0; ks < 2; ++ks) {
      float blk[8];
      const int cw = 1152 + dir * 64 + 32 * ks + 8 * g4;
      load_shift8(Ub + UR + cw, t, T, path, PRM + 192 + 32 * ks + 8 * g4, blk);
#pragma unroll
      for (int j = 0; j < 8; ++j) awl[ks][j] = (short)f2bf(tanhf(blk[j]));
      const int ca = 1280 + dir * 64 + 32 * ks + 8 * g4;
      load_shift8(Ub + UR + ca, t, T, path, PRM + 256 + 32 * ks + 8 * g4, blk);
#pragma unroll
      for (int j = 0; j < 8; ++j) aal[ks][j] = (short)f2bf(blk[j]);
    }
#pragma unroll
    for (int nt = 0; nt < 4; ++nt) {
      f32x4 aw = {0.f, 0.f, 0.f, 0.f}, aa = {0.f, 0.f, 0.f, 0.f};
#pragma unroll
      for (int ks = 0; ks < 2; ++ks) {
        aw = __builtin_amdgcn_mfma_f32_16x16x32_bf16(awl[ks], wf[(nt * 2 + ks) * 64], aw, 0, 0, 0);
        aa = __builtin_amdgcn_mfma_f32_16x16x32_bf16(aal[ks], wf[(8 + nt * 2 + ks) * 64], aa, 0, 0, 0);
      }
      const int col = nt * 16 + slot;
      const float w0v = PRM[576 + col];
      const float a0v = PRM[640 + col];
#pragma unroll
      for (int i = 0; i < 4; ++i) {
        const int tt = 4 * g4 + i;
        LW[tt * RS + col] = __expf(-0.6065306597126334f * sigm(w0v + aw[i]));
        LB[tt * RS + col] = sigm(a0v + aa[i]);
      }
    }
  }
  {
    float kap[16], kr[16], av[16];
    float ss = 0.f;
#pragma unroll
    for (int j4 = 0; j4 < 4; ++j4) {
      f4v k4 = *(const f4v*)(LKH + tl * RS + c0 + 4 * j4);
      f4v a4 = *(const f4v*)(LB + tl * RS + c0 + 4 * j4);
#pragma unroll
      for (int e = 0; e < 4; ++e) {
        kr[4 * j4 + e] = k4[e];
        av[4 * j4 + e] = a4[e];
        kap[4 * j4 + e] = k4[e] * PRM[384 + c0 + 4 * j4 + e];
        ss += kap[4 * j4 + e] * kap[4 * j4 + e];
      }
    }
    ss += shx<1>(ss);
    ss += shx<2>(ss);
    const float inv = 1.f / fmaxf(sqrtf(ss), 1e-12f);
#pragma unroll
    for (int j4 = 0; j4 < 4; ++j4) {
      f4v kh4, kt4, b4;
#pragma unroll
      for (int e = 0; e < 4; ++e) {
        const int j = 4 * j4 + e;
        const float kh = kap[j] * inv;
        kh4[e] = kh;
        kt4[e] = kr[j] * (1.f + (av[j] - 1.f) * PRM[448 + c0 + j]);
        b4[e] = kh * av[j];
      }
      *(f4v*)(LKH + tl * RS + c0 + 4 * j4) = kh4;
      *(f4v*)(LKT + tl * RS + c0 + 4 * j4) = kt4;
      *(f4v*)(LB + tl * RS + c0 + 4 * j4) = b4;
    }
  }
}

__device__ __forceinline__ void rwkv_finalize_tile(const bfu* Ub, bfu* Mb, const float* PRM, const float* buf, int t0, int h,
                                                   bool first_half, int lane) {
  const float *LR = buf, *LV = buf + 16 * RS, *BON = buf + 96 * RS;
  const int tl = lane >> 2, c0 = (lane & 3) * 16;
  const int t = t0 + tl;
  bfu* mp = Mb + (size_t)t * DM + c0;
  float y[16];
#pragma unroll
  for (int j4 = 0; j4 < 4; ++j4) {
    f4v v = *(const f4v*)(LR + tl * RS + c0 + 4 * j4);
    y[4 * j4] = v[0]; y[4 * j4 + 1] = v[1]; y[4 * j4 + 2] = v[2]; y[4 * j4 + 3] = v[3];
  }
  if (first_half) {
    *(uint4*)mp = pack8(y);
    *(uint4*)(mp + 8) = pack8(y + 8);
  } else {
    float pp[16], gz[16], vv[16];
    ld8(mp, pp); ld8(mp + 8, pp + 8);
    const bfu* gp = Ub + (size_t)t * UC + URZ + h * 64 + c0;
    ld8(gp, gz); ld8(gp + 8, gz + 8);
#pragma unroll
    for (int j4 = 0; j4 < 4; ++j4) {
      f4v v = *(const f4v*)(LV + tl * RS + c0 + 4 * j4);
      vv[4 * j4] = v[0]; vv[4 * j4 + 1] = v[1]; vv[4 * j4 + 2] = v[2]; vv[4 * j4 + 3] = v[3];
    }
    const float bon = BON[tl];
    float ss = 0.f;
#pragma unroll
    for (int j = 0; j < 16; ++j) { y[j] += pp[j]; ss += y[j] * y[j]; }
    ss += shx<1>(ss);
    ss += shx<2>(ss);
    const float rstd = rsqrtf(ss * (1.f / 64.f) + EPSF);
#pragma unroll
    for (int j = 0; j < 16; ++j) {
      float o = y[j] * rstd * PRM[512 + c0 + j] + bon * vv[j];
      y[j] = o * siluf(gz[j]);
    }
    *(uint4*)mp = pack8(y);
    *(uint4*)(mp + 8) = pack8(y + 8);
  }
}

__device__ void rwkv_job(const Params& p, int l, int path, int unit, int wv) {
  float* smem = SMEM;
  const int tid = opaque_tid(wv);
  const int wave = wv, lane = tid & 63;
  const int b = unit / 6, h = unit % 6;
  const int T = path ? 2048 : 256, NT = T >> 4;
  if (wave >= 4) {
#pragma unroll 1
    for (int i = 0; i < NT + 2; ++i) __syncthreads();
    return;
  }
  const int dir = wave & 1;
  const size_t tok0 = path ? (size_t)NTP + (size_t)b * 2048 : (size_t)b * 256;
  const bfu* Ub = p.U + tok0 * UC;
  float* D = smem + dir * (2 * RBUF + 704);
  float* PRM = D + 2 * RBUF;
  if (wave < 2) {
    f2v S[32];
    if (path) {
      const float* sp = p.sR + ((((size_t)(b * 2 + l) * 2 + dir) * 6 + h) * 64 + lane) * 64;
#pragma unroll
      for (int k4 = 0; k4 < 16; ++k4) {
        f4v v = ((const f4v*)sp)[k4];
        S[2 * k4] = v.xy; S[2 * k4 + 1] = v.zw;
      }
    } else {
#pragma unroll
      for (int k = 0; k < 32; ++k) S[k] = (f2v){0.f, 0.f};
    }
    __syncthreads();
#pragma unroll 1
    for (int it = 0; it <= NT; ++it) {
      if (it < NT) {
        float* buf = D + (it & 1) * RBUF;
        float *LR = buf, *LV = buf + 16 * RS, *LKH = buf + 32 * RS, *LW = buf + 48 * RS, *LB = buf + 64 * RS, *LKT = buf + 80 * RS;
#pragma unroll 1
        for (int s_ = 0; s_ < 16; ++s_) {
          const int s = dir ? 15 - s_ : s_;
          const f4v* kh4 = (const f4v*)(LKH + s * RS);
          const f4v* w4 = (const f4v*)(LW + s * RS);
          const f4v* b4 = (const f4v*)(LB + s * RS);
          const f4v* kt4 = (const f4v*)(LKT + s * RS);
          const f4v* r4 = (const f4v*)(LR + s * RS);
          f2v ska = {0.f, 0.f}, skb = {0.f, 0.f};
#pragma unroll
          for (int k4 = 0; k4 < 16; ++k4) {
            const f4v x = kh4[k4];
            ska = __builtin_elementwise_fma(S[2 * k4], x.xy, ska);
            skb = __builtin_elementwise_fma(S[2 * k4 + 1], x.zw, skb);
          }
          const float sk = (ska.x + ska.y) + (skb.x + skb.y);
          const float vv = LV[s * RS + lane];
          const f2v vv2 = {vv, vv}, nsk2 = {-sk, -sk};
          f2v ya = {0.f, 0.f}, yb = {0.f, 0.f};
#pragma unroll
          for (int k4 = 0; k4 < 16; ++k4) {
            const f4v w = w4[k4], bb = b4[k4], kt = kt4[k4], r = r4[k4];
            f2v t0 = vv2 * kt.xy, t1 = vv2 * kt.zw;
            t0 = __builtin_elementwise_fma(nsk2, bb.xy, t0);
            t1 = __builtin_elementwise_fma(nsk2, bb.zw, t1);
            S[2 * k4] = __builtin_elementwise_fma(S[2 * k4], w.xy, t0);
            S[2 * k4 + 1] = __builtin_elementwise_fma(S[2 * k4 + 1], w.zw, t1);
            ya = __builtin_elementwise_fma(S[2 * k4], r.xy, ya);
            yb = __builtin_elementwise_fma(S[2 * k4 + 1], r.zw, yb);
            if ((k4 & 3) == 3) __builtin_amdgcn_sched_barrier(0);
          }
          LR[s * RS + lane] = (ya.x + ya.y) + (yb.x + yb.y);
        }
      }
      __syncthreads();
    }
    if (path == 0) {
      float* op = p.out + OUT_R + ((((size_t)(b * 2 + l) * 2 + dir) * 6 + h) * 64 + lane) * 64;
#pragma unroll
      for (int k4 = 0; k4 < 16; ++k4) {
        f4v v;
        v.xy = S[2 * k4]; v.zw = S[2 * k4 + 1];
        ((f4v*)op)[k4] = v;
      }
    }
  } else {
    bfu* Mb = p.HM + tok0 * DM + 384 + h * 64;
    {
      const float* mu0 = p.r_mu + l * 1408;
      PRM[lane] = mu0[h * 64 + lane];
      PRM[64 + lane] = mu0[384 + h * 64 + lane];
      PRM[128 + lane] = mu0[768 + h * 64 + lane];
      PRM[192 + lane] = mu0[1152 + dir * 64 + lane];
      PRM[256 + lane] = mu0[1280 + dir * 64 + lane];
      PRM[320 + lane] = p.r_rk[l * 384 + h * 64 + lane];
      PRM[384 + lane] = p.r_kk[l * 384 + h * 64 + lane];
      PRM[448 + lane] = p.r_ka[l * 384 + h * 64 + lane];
      PRM[512 + lane] = p.r_norm[l * 384 + h * 64 + lane];
      PRM[576 + lane] = p.r_w0[(l * 2 + dir) * 384 + h * 64 + lane];
      PRM[640 + lane] = p.r_a0[(l * 2 + dir) * 384 + h * 64 + lane];
    }
    const bf16x8* wf = (const bf16x8*)p.WF + ((size_t)((l * 2 + dir) * 6 + h) * 16) * 64 + lane;
    rwkv_prep_tile(Ub, PRM, D, wf, (dir ? NT - 1 : 0) * 16, T, path, dir, h, lane);
    __syncthreads();
#pragma unroll 1
    for (int it = 0; it <= NT; ++it) {
      if (it >= 1) {
        const int k = it - 1;
        rwkv_finalize_tile(Ub, Mb, PRM, D + (k & 1) * RBUF, (dir ? NT - 1 - k : k) * 16, h, k < NT / 2, lane);
      }
      if (it + 1 < NT) {
        const int k = it + 1;
        rwkv_prep_tile(Ub, PRM, D + (k & 1) * RBUF, wf, (dir ? NT - 1 - k : k) * 16, T, path, dir, h, lane);
      }
      __syncthreads();
    }
  }
}

#define LS 72
__device__ void mlstm_job(const Params& p, int l, int path, int unit, int wv) {
  float* smem = SMEM;
  const int tid = opaque_tid(wv);
  const int wave = tid >> 6, lane = tid & 63;
  const int dir = wave >> 2, w = wave & 3, tg = tid & 255;
  const int b = unit / 6, h = unit % 6;
  const int T = path ? 2048 : 256, NC = T >> 6;
  const size_t tok0 = path ? (size_t)NTP + (size_t)b * 2048 : (size_t)b * 256;
  const bfu* Ub = p.U + tok0 * UC;
  bfu* Mb = p.HM + tok0 * DM + h * 64;
  bfu* base = (bfu*)smem + dir * (288 * LS);
  bfu *KWT = base, *VT = base + 64 * LS, *CT = base + 144 * LS, *P = base + 224 * LS;
  float* fb = smem + (2 * 288 * LS * 2) / 4 + dir * 272;
  float *X = fb, *MX = fb + 64, *BC = fb + 128, *WK = fb + 192, *SC = fb + 256;
  const int slot = lane & 15, g4 = lane >> 4;
  f32x4 C[5];
  float mstate = 0.f;
#pragma unroll
  for (int nt = 0; nt < 5; ++nt) C[nt] = (f32x4){0.f, 0.f, 0.f, 0.f};
  if (path) {
    const size_t sb = ((size_t)(b * 2 + l) * 2 + dir) * 6 + h;
    mstate = p.sm[sb];
#pragma unroll
    for (int nt = 0; nt < 4; ++nt)
#pragma unroll
      for (int i = 0; i < 4; ++i) C[nt][i] = p.sC[(sb * 64 + 16 * w + 4 * g4 + i) * 64 + nt * 16 + slot];
    if (slot == 0)
#pragma unroll
      for (int i = 0; i < 4; ++i) C[4][i] = p.sn[sb * 64 + 16 * w + 4 * g4 + i];
  }
  for (int i = tg; i < 16 * LS; i += 256) VT[64 * LS + i] = (i < 64) ? (bfu)0x3F80 : (bfu)0;
  const float bi = p.m_bi[l * 12 + dir * 6 + h], bff = p.m_bf[l * 12 + dir * 6 + h];
  __syncthreads();
  for (int ic = 0; ic < NC; ++ic) {
    const int ch = dir ? NC - 1 - ic : ic;
    const int c0t = ch * 64;
    if (w == 0) {
      const bfu* ur = Ub + (size_t)(c0t + lane) * UC;
      const float ip = bf2f(ur[UM_I + dir * 6 + h]) + bi;
      const float fp = bf2f(ur[UM_F + dir * 6 + h]) + bff;
      const float lf = fminf(fp, 0.f) - log1pf(__expf(-fabsf(fp)));
      float bs = lf;
      if (dir == 0) {
#pragma unroll
        for (int o = 1; o < 64; o <<= 1) { float v = bperm(lane - o, bs); if (lane >= o) bs += v; }
      } else {
#pragma unroll
        for (int o = 1; o < 64; o <<= 1) { float v = bperm(lane + o, bs); if (lane + o < 64) bs += v; }
      }
      const float x = ip - bs;
      float pm = x;
      if (dir == 0) {
#pragma unroll
        for (int o = 1; o < 64; o <<= 1) { float v = bperm(lane - o, pm); if (lane >= o) pm = fmaxf(pm, v); }
      } else {
#pragma unroll
        for (int o = 1; o < 64; o <<= 1) { float v = bperm(lane + o, pm); if (lane + o < 64) pm = fmaxf(pm, v); }
      }
      const int last = dir ? 0 : 63;
      const float pmtot = bperm(last, pm), bL = bperm(last, bs);
      const float mref = fmaxf(mstate, pmtot);
      X[lane] = x; MX[lane] = fmaxf(mstate, pm); BC[lane] = bs; WK[lane] = __expf(x - mref);
      if (lane == 0) { SC[0] = __expf(mstate - mref); SC[1] = bL + mref; }
    }
#pragma unroll
    for (int nt = 0; nt < 5; ++nt) {
      uint2 o;
      o.x = pack2(C[nt][0], C[nt][1]);
      o.y = pack2(C[nt][2], C[nt][3]);
      *(uint2*)(CT + (nt * 16 + slot) * LS + 16 * w + 4 * g4) = o;
    }
    __syncthreads();
    {
      const int s = tg >> 2, cq = (tg & 3) * 16;
      const bfu* ur = Ub + (size_t)(c0t + s) * UC + h * 64 + cq;
      float kf[16];
      ld8(ur + UM_K, kf); ld8(ur + UM_K + 8, kf + 8);
      const float sc = 0.125f * WK[s];
      const uint4 v0 = *(const uint4*)(ur + UM_V), v1 = *(const uint4*)(ur + UM_V + 8);
      const unsigned vv[8] = {v0.x, v0.y, v0.z, v0.w, v1.x, v1.y, v1.z, v1.w};
#pragma unroll
      for (int j = 0; j < 16; ++j) {
        KWT[(cq + j) * LS + s] = f2bf(kf[j] * sc);
        VT[(cq + j) * LS + s] = (bfu)((j & 1) ? (vv[j >> 1] >> 16) : (vv[j >> 1] & 0xffffu));
      }
    }
    bf16x8 aq[2];
    {
      const bfu* qp = Ub + (size_t)(c0t + 16 * w + slot) * UC + UM_Q + h * 64 + 8 * g4;
      aq[0] = *(const bf16x8*)qp;
      aq[1] = *(const bf16x8*)(qp + 32);
      f32x4 aS[4];
#pragma unroll
      for (int nt = 0; nt < 4; ++nt) {
        const bfu* kp = Ub + (size_t)(c0t + nt * 16 + slot) * UC + UM_K + h * 64 + 8 * g4;
        bf16x8 k0 = *(const bf16x8*)kp, k1 = *(const bf16x8*)(kp + 32);
        aS[nt] = (f32x4){0.f, 0.f, 0.f, 0.f};
        aS[nt] = __builtin_amdgcn_mfma_f32_16x16x32_bf16(aq[0], k0, aS[nt], 0, 0, 0);
        aS[nt] = __builtin_amdgcn_mfma_f32_16x16x32_bf16(aq[1], k1, aS[nt], 0, 0, 0);
      }
#pragma unroll
      for (int i = 0; i < 4; ++i) {
        const int t = 16 * w + 4 * g4 + i;
        const float mxt = MX[t];
#pragma unroll
        for (int nt = 0; nt < 4; ++nt) {
          const int s = nt * 16 + slot;
          const bool keep = dir ? (s >= t) : (s <= t);
          const float pv = keep ? aS[nt][i] * 0.125f * __expf(X[s] - mxt) : 0.f;
          P[t * LS + s] = f2bf(pv);
        }
      }
    }
    __syncthreads();
    f32x4 hv[4];
    {
      bf16x8 ap[2];
      const bfu* pp = P + (16 * w + slot) * LS + 8 * g4;
      ap[0] = *(const bf16x8*)pp; ap[1] = *(const bf16x8*)(pp + 32);
      f32x4 aC[5], aP[5];
#pragma unroll
      for (int nt = 0; nt < 5; ++nt) {
        aC[nt] = (f32x4){0.f, 0.f, 0.f, 0.f};
        aP[nt] = (f32x4){0.f, 0.f, 0.f, 0.f};
#pragma unroll
        for (int ks = 0; ks < 2; ++ks) {
          bf16x8 bc = *(const bf16x8*)(CT + (nt * 16 + slot) * LS + 32 * ks + 8 * g4);
          bf16x8 bv = *(const bf16x8*)(VT + (nt * 16 + slot) * LS + 32 * ks + 8 * g4);
          aC[nt] = __builtin_amdgcn_mfma_f32_16x16x32_bf16(aq[ks], bc, aC[nt], 0, 0, 0);
          aP[nt] = __builtin_amdgcn_mfma_f32_16x16x32_bf16(ap[ks], bv, aP[nt], 0, 0, 0);
        }
      }
#pragma unroll
      for (int i = 0; i < 4; ++i) {
        const int t = 16 * w + 4 * g4 + i;
        const float mxt = MX[t];
        const float sc = __expf(mstate - mxt);
        float den = sc * aC[4][i] + aP[4][i];
        den = bperm(lane & 48, den);
        const float lower = __expf(-(BC[t] + mxt));
        const float inv = 1.f / fmaxf(fabsf(den), lower);
#pragma unroll
        for (int nt = 0; nt < 4; ++nt) hv[nt][i] = (sc * aC[nt][i] + aP[nt][i]) * inv;
      }
    }
#pragma unroll
    for (int i = 0; i < 4; ++i) {
      const int t = c0t + 16 * w + 4 * g4 + i;
      bfu* mp = Mb + (size_t)t * DM;
      if (ic < NC / 2) {
#pragma unroll
        for (int nt = 0; nt < 4; ++nt) mp[nt * 16 + slot] = f2bf(hv[nt][i]);
      } else {
        float hh[4];
        float ss = 0.f;
#pragma unroll
        for (int nt = 0; nt < 4; ++nt) { hh[nt] = hv[nt][i] + bf2f(mp[nt * 16 + slot]); ss += hh[nt] * hh[nt]; }
        ss += shx<1>(ss); ss += shx<2>(ss); ss += shx<4>(ss); ss += shx<8>(ss);
        const float rstd = rsqrtf(ss * (1.f / 64.f) + EPSF);
        const bfu* ur = Ub + (size_t)t * UC + h * 64;
#pragma unroll
        for (int nt = 0; nt < 4; ++nt) {
          const int e = nt * 16 + slot;
          const float o = bf2f(ur[UM_O + e]), z = bf2f(ur[UM_Z + e]);
          mp[e] = f2bf(hh[nt] * rstd * p.m_norm[l * 384 + h * 64 + e] * sigm(o) * siluf(z));
        }
      }
    }
    {
      const float dec = SC[0];
      bf16x8 ak[2];
      const bfu* kp = KWT + (16 * w + slot) * LS + 8 * g4;
      ak[0] = *(const bf16x8*)kp; ak[1] = *(const bf16x8*)(kp + 32);
#pragma unroll
      for (int nt = 0; nt < 5; ++nt) {
        f32x4 aD = {0.f, 0.f, 0.f, 0.f};
#pragma unroll
        for (int ks = 0; ks < 2; ++ks) {
          bf16x8 bv = *(const bf16x8*)(VT + (nt * 16 + slot) * LS + 32 * ks + 8 * g4);
          aD = __builtin_amdgcn_mfma_f32_16x16x32_bf16(ak[ks], bv, aD, 0, 0, 0);
        }
#pragma unroll
        for (int i = 0; i < 4; ++i) C[nt][i] = dec * C[nt][i] + aD[i];
      }
      mstate = SC[1];
    }
    __syncthreads();
  }
  if (path == 0) {
    const size_t sb = ((size_t)(b * 2 + l) * 2 + dir) * 6 + h;
#pragma unroll
    for (int nt = 0; nt < 4; ++nt)
#pragma unroll
      for (int i = 0; i < 4; ++i) p.out[OUT_C + (sb * 64 + 16 * w + 4 * g4 + i) * 64 + nt * 16 + slot] = C[nt][i];
    if (slot == 0)
#pragma unroll
      for (int i = 0; i < 4; ++i) p.out[OUT_N + sb * 64 + 16 * w + 4 * g4 + i] = C[4][i];
    if (tg == 0) p.out[OUT_M + sb] = mstate;
  }
}

__device__ void lru_job(const Params& p, int l, int path, int unit, int wv) {
  float* smem = SMEM;
  const int tid = opaque_tid(wv);
  const int wave = tid >> 6, lane = tid & 63;
  const int dir = wave >> 2, w = wave & 3, tg = tid & 255;
  const int b = unit >> 2, n = unit & 3;
  const int T = path ? 2048 : 256, NT = T >> 6;
  const size_t tok0 = path ? (size_t)NTP + (size_t)b * 2048 : (size_t)b * 256;
  const bfu* Ub = p.U + tok0 * UC;
  bfu* Mb = p.HM + tok0 * DM + 768 + n * 64;
  unsigned char* sb_ = (unsigned char*)smem + dir * 41984;
  bfu* XC = (bfu*)sb_;
  float* AA = (float*)(sb_ + 9216);
  float* BB = AA + 4096;
  const int slot = lane & 15, g4 = lane >> 4;
  const bf16x8* lf = (const bf16x8*)p.LF + ((size_t)((l * 2 + dir) * 4 + n) * 16) * 64 + lane;
  float hstate = 0.f;
  if (path) hstate = p.sL[((size_t)(b * 2 + l) * 2 + dir) * 256 + n * 64 + lane];
  for (int it = 0; it < NT; ++it) {
    const int ti = dir ? NT - 1 - it : it;
    const int t0 = ti * 64;
    const int tl = tg >> 2, cq = (tg & 3) * 16;
    {
      const int t = t0 + tl;
      float acc[16];
#pragma unroll
      for (int j = 0; j < 16; ++j) acc[j] = p.l_conv_b[l * 256 + n * 64 + cq + j];
#pragma unroll
      for (int tap = 0; tap < 4; ++tap) {
        const int ts = t + tap - 2;
        if (ts >= 0 && ts < T) {
          float xv[16];
          const bfu* ur = Ub + (size_t)ts * UC + UL + n * 64 + cq;
          ld8(ur, xv); ld8(ur + 8, xv + 8);
#pragma unroll
          for (int j = 0; j < 16; ++j) acc[j] += xv[j] * p.l_conv[(l * 4 + tap) * 256 + n * 64 + cq + j];
        }
      }
      *(uint4*)(XC + tl * LS + cq) = pack8(acc);
      *(uint4*)(XC + tl * LS + cq + 8) = pack8(acc + 8);
    }
    __syncthreads();
    {
      bf16x8 ax[2];
      const bfu* xp = XC + (16 * w + slot) * LS + 8 * g4;
      ax[0] = *(const bf16x8*)xp; ax[1] = *(const bf16x8*)(xp + 32);
#pragma unroll
      for (int nt = 0; nt < 4; ++nt) {
        f32x4 ga = {0.f, 0.f, 0.f, 0.f}, gx = {0.f, 0.f, 0.f, 0.f};
#pragma unroll
        for (int ks = 0; ks < 2; ++ks) {
          ga = __builtin_amdgcn_mfma_f32_16x16x32_bf16(ax[ks], lf[(nt * 2 + ks) * 64], ga, 0, 0, 0);
          gx = __builtin_amdgcn_mfma_f32_16x16x32_bf16(ax[ks], lf[(8 + nt * 2 + ks) * 64], gx, 0, 0, 0);
        }
        const int o = nt * 16 + slot;
        const int chn = (l * 2 + dir) * 256 + n * 64 + o;
        const float bav = p.l_ba[chn], bxv = p.l_bx[chn];
        const float lam = p.l_lambda[chn];
        const float sp = fmaxf(-lam, 0.f) + log1pf(__expf(-fabsf(lam)));
#pragma unroll
        for (int i = 0; i < 4; ++i) {
          const int t = 16 * w + 4 * g4 + i;
          const float rg = sigm(ga[i] + bav), ig = sigm(gx[i] + bxv);
          const float la = -8.f * rg * sp;
          const float a = __expf(la);
          const float bt = sqrtf(fmaxf(-expm1f(2.f * la), 0.f)) * ig * bf2f(XC[t * LS + o]);
          AA[t * 64 + o] = a;
          BB[t * 64 + o] = bt;
        }
      }
    }
    __syncthreads();
    if (w == 0) {
#pragma unroll 4
      for (int s_ = 0; s_ < 64; ++s_) {
        const int s = dir ? 63 - s_ : s_;
        hstate = AA[s * 64 + lane] * hstate + BB[s * 64 + lane];
        BB[s * 64 + lane] = hstate;
      }
    }
    __syncthreads();
    {
      const int t = t0 + tl;
      bfu* mp = Mb + (size_t)t * DM + cq;
      float y[16];
#pragma unroll
      for (int j = 0; j < 16; ++j) y[j] = BB[tl * 64 + cq + j];
      if (it >= NT / 2) {
        float pp[16], gz[16];
        ld8(mp, pp); ld8(mp + 8, pp + 8);
        const bfu* gp = Ub + (size_t)t * UC + ULZ + n * 64 + cq;
        ld8(gp, gz); ld8(gp + 8, gz + 8);
#pragma unroll
        for (int j = 0; j < 16; ++j) y[j] = (y[j] + pp[j]) * siluf(gz[j]);
      }
      *(uint4*)mp = pack8(y);
      *(uint4*)(mp + 8) = pack8(y + 8);
    }
    __syncthreads();
  }
  if (path == 0 && w == 0) p.out[OUT_L + ((size_t)(b * 2 + l) * 2 + dir) * 256 + n * 64 + lane] = hstate;
}

__device__ void phase_mix(const Params& p, int l, int wv) {
  __shared__ int sjob;
  for (;;) {
    if (wv == 0 && opaque_tid(0) == 0) sjob = (int)atomicAdd(&p.ctr[l], 1u);
    __syncthreads();
    const int job = __builtin_amdgcn_readfirstlane(sjob);
    __syncthreads();
    if (job >= 640) break;
    int type, path, idx;
    if (job < 48) { type = 0; path = 1; idx = job; }
    else if (job < 96) { type = 1; path = 1; idx = job - 48; }
    else if (job < 128) { type = 2; path = 1; idx = job - 96; }
    else if (job < 320) { type = 0; path = 0; idx = job - 128; }
    else if (job < 512) { type = 1; path = 0; idx = job - 320; }
    else { type = 2; path = 0; idx = job - 512; }
    if (type == 0) { if (PHM & 16) rwkv_job(p, l, path, idx, wv); }
    else if (type == 1) { if (PHM & 32) mlstm_job(p, l, path, idx, wv); }
    else { if (PHM & 64) lru_job(p, l, path, idx, wv); }
    __syncthreads();
    if (PROBE_SEL && wv == 0 && opaque_tid(0) == 0) {
      const int cat = job < 48 ? 0 : job < 96 ? 2 : job < 128 ? 3 : job < 320 ? 1 : job < 512 ? 4 : 5;
      atomicMax(&p.ts[16 + l * 8 + cat], (unsigned long long)wall_clock64());
    }
  }
}

template <bool USE_GRID>
__global__ void __launch_bounds__(NTHREADS) mega_kernel(Params p) {
  const int wv = __builtin_amdgcn_readfirstlane((int)(threadIdx.x >> 6));
  const int lo = (int)p.ph_lo, hi = (int)p.ph_hi;
  for (int ph = lo; ph < hi; ++ph) {
    if (ph == 0) { if (PHM & 1) phase_mod(p, wv); }
    else if (ph == 1) { if (PHM & 2) phase_h0(p, wv); }
    else {
      const int l = (ph - 2) / 3, s = (ph - 2) % 3;
      if (s == 0) { if (PHM & 4) phase_inproj(p, l, wv); }
      else if (s == 1) phase_mix(p, l, wv);
      else { if (PHM & 8) phase_outproj(p, l, wv); }
    }
    if constexpr (USE_GRID) {
      if (ph + 1 < hi || PROBE_SEL) cg::this_grid().sync();
    }
    if (PROBE_SEL && blockIdx.x == 0 && wv == 0 && opaque_tid(0) == 0) p.ts[ph + 1] = wall_clock64();

  }
  if (PROBE_SEL && blockIdx.x == 0 && wv == 0 && opaque_tid(0) == 0) {
    const unsigned long long tend = wall_clock64();
    unsigned long long d = 0;
    if (PROBE_SEL == 1) d = p.ts[2] - p.ts[1];
    else if (PROBE_SEL == 2) d = p.ts[3] - p.ts[2];
    else if (PROBE_SEL == 3) d = p.ts[4] - p.ts[3];
    else if (PROBE_SEL == 4) d = p.ts[5] - p.ts[4];
    else if (PROBE_SEL >= 5 && PROBE_SEL <= 10) d = p.ts[16 + PROBE_SEL - 5] - p.ts[3];
    else if (PROBE_SEL == 11) d = p.ts[8] - p.ts[7];
    while ((unsigned long long)wall_clock64() - tend < PROBE_MULT * d) asm volatile("s_sleep 2");
  }
}

extern "C" void kernel_launch(void* const* d_in, const int* in_sizes, int n_in, void* d_out, int out_size, void* d_ws,
                              size_t ws_size, hipStream_t stream) {
  static int grid = 0;
  if (grid == 0) {
    if (n_in != 34 || ws_size < WS_END) {
      fprintf(stderr, "kernel_launch: unexpected n_in %d or ws_size %zu (< %llu)\n", n_in, ws_size, WS_END);
      grid = -1;
      return;
    }
    int dev = 0, cus = 0, per_cu = 0;
    hipGetDevice(&dev);
    hipDeviceGetAttribute(&cus, hipDeviceAttributeMultiprocessorCount, dev);
#if COOP
    hipFuncSetAttribute((const void*)mega_kernel<true>, hipFuncAttributeMaxDynamicSharedMemorySize, LDS_BYTES);
    hipOccupancyMaxActiveBlocksPerMultiprocessor(&per_cu, (const void*)mega_kernel<true>, NTHREADS, LDS_BYTES);
#else
    hipFuncSetAttribute((const void*)mega_kernel<false>, hipFuncAttributeMaxDynamicSharedMemorySize, LDS_BYTES);
    hipOccupancyMaxActiveBlocksPerMultiprocessor(&per_cu, (const void*)mega_kernel<false>, NTHREADS, LDS_BYTES);
#endif
    if (per_cu < 1) { fprintf(stderr, "kernel_launch: occupancy query returned %d\n", per_cu); per_cu = 1; }
    if (per_cu > 1) per_cu = 1;
    grid = cus * per_cu;
  }
  if (grid < 0) return;
  Params p{};
  const float** pf = (const float**)&p;
  for (int i = 0; i < 34; ++i) pf[i] = (const float*)d_in[i];
  p.out = (float*)d_out;
  p.U = (bfu*)((char*)d_ws + WS_U);
  p.HM = (bfu*)((char*)d_ws + WS_HM);
  p.MOD = (float*)((char*)d_ws + WS_MOD);
  p.ctr = (unsigned int*)((char*)d_ws + WS_CTR);
  p.WF = (bfu*)((char*)d_ws + WS_WF);
  p.LF = (bfu*)((char*)d_ws + WS_LF);
  p.ts = (unsigned long long*)((char*)d_ws + WS_TS);
#if COOP
  p.ph_lo = 0; p.ph_hi = 8;
  void* args[] = {&p};
  hipError_t e = hipLaunchCooperativeKernel((const void*)mega_kernel<true>, dim3(grid), dim3(NTHREADS), args, LDS_BYTES, stream);
  if (e != hipSuccess) fprintf(stderr, "cooperative launch failed: %s (grid %d)\n", hipGetErrorString(e), grid);
#else
  for (int ph = 0; ph < 8; ++ph) {
    p.ph_lo = ph; p.ph_hi = ph + 1;
    hipLaunchKernelGGL(mega_kernel<false>, dim3(grid), dim3(NTHREADS), LDS_BYTES, stream, p);
  }
#endif
}
```

```cpp
#include <hip/hip_runtime.h>
#include <hip/hip_cooperative_groups.h>
#include <cstdio>
namespace cg = cooperative_groups;

#ifndef COOP
#define COOP 1
#endif

typedef __attribute__((ext_vector_type(8))) short bf16x8;
typedef __attribute__((ext_vector_type(4))) float f32x4;
typedef unsigned short bfu;

#define NTOK 24576
#define NTP 8192
#define DM 1024
#define UC 4248
#define EPSF 1e-6f
#define UM_Q 0
#define UM_K 384
#define UM_V 768
#define UM_O 1152
#define UM_Z 1536
#define UM_I 1920
#define UM_F 1932
#define UR 1944
#define URZ 3352
#define UL 3736
#define ULZ 3992

#define OUT_Y 0
#define OUT_C 25165824
#define OUT_N 28311552
#define OUT_M 28360704
#define OUT_R 28361472
#define OUT_L 31507200

#define WS_U 0ull
#define WS_HM 208797696ull
#define WS_MOD 259129344ull
#define WS_CTR 259350528ull
#define WS_WF 259350784ull
#define WS_LF 259744000ull
#define WS_END 260006144ull

#ifndef PHM
#define PHM 127
#endif
#ifndef PROBE_SEL
#define PROBE_SEL 0
#endif
#define PROBE_MULT 4
#define WS_TS 260006144ull
#define LDS_BYTES 114688
#define NTHREADS 512

extern __shared__ __attribute__((aligned(16))) unsigned char lds_raw[];
#define SMEM ((float*)lds_raw)

struct Params {
  const float *x_prompt, *x_sample, *c, *sC, *sn, *sm, *sR, *sL, *c_ctx, *g_pre, *g_post, *w_mod, *b_mod, *w_in, *w_out,
      *m_bi, *m_bf, *m_norm, *r_mu, *r_w0, *r_w2, *r_a0, *r_a2, *r_kk, *r_ka, *r_rk, *r_norm, *l_conv, *l_conv_b, *l_wa,
      *l_ba, *l_wx, *l_bx, *l_lambda;
  float* out;
  bfu* U;
  bfu* HM;
  float* MOD;
  unsigned int* ctr;
  bfu* WF;
  bfu* LF;
  unsigned long long* ts;
  long long ph_lo, ph_hi;
};

__device__ __forceinline__ int opaque_tid(int wv) {
  int ln = __builtin_amdgcn_mbcnt_hi(~0u, __builtin_amdgcn_mbcnt_lo(~0u, 0u));
  asm volatile("" : "+v"(ln));
  return wv * 64 + ln;
}
template <int M>
__device__ __forceinline__ float shx(float v) {
  return __builtin_bit_cast(float, __builtin_amdgcn_ds_swizzle(__builtin_bit_cast(int, v), (M << 10) | 0x1F));
}
__device__ __forceinline__ float bperm(int srclane, float v) {
  return __builtin_bit_cast(float, __builtin_amdgcn_ds_bpermute(srclane << 2, __builtin_bit_cast(int, v)));
}
__device__ __forceinline__ bfu f2bf(float f) {
  unsigned u = __float_as_uint(f);
  u += 0x7fffu + ((u >> 16) & 1u);
  return (bfu)(u >> 16);
}
__device__ __forceinline__ float bf2f(bfu h) { return __uint_as_float(((unsigned)h) << 16); }
__device__ __forceinline__ unsigned pack2(float a, float b) { return (unsigned)f2bf(a) | ((unsigned)f2bf(b) << 16); }
__device__ __forceinline__ float sigm(float x) { return 1.f / (1.f + __expf(-x)); }
__device__ __forceinline__ float siluf(float x) { return x / (1.f + __expf(-x)); }
__device__ __forceinline__ void unpack8(uint4 v, float* f) {
  f[0] = __uint_as_float(v.x << 16); f[1] = __uint_as_float(v.x & 0xffff0000u);
  f[2] = __uint_as_float(v.y << 16); f[3] = __uint_as_float(v.y & 0xffff0000u);
  f[4] = __uint_as_float(v.z << 16); f[5] = __uint_as_float(v.z & 0xffff0000u);
  f[6] = __uint_as_float(v.w << 16); f[7] = __uint_as_float(v.w & 0xffff0000u);
}
__device__ __forceinline__ void ld8(const bfu* p, float* f) { unpack8(*(const uint4*)p, f); }
__device__ __forceinline__ void ld8acc(const bfu* p, float* f) {
  float t[8]; unpack8(*(const uint4*)p, t);
#pragma unroll
  for (int j = 0; j < 8; ++j) f[j] += t[j];
}
__device__ __forceinline__ uint4 pack8(const float* f) {
  uint4 v; v.x = pack2(f[0], f[1]); v.y = pack2(f[2], f[3]); v.z = pack2(f[4], f[5]); v.w = pack2(f[6], f[7]);
  return v;
}
__device__ __forceinline__ void load_shift8(const bfu* Ub, int t, int T, int path, const float* mu, float* blk) {
  float u[8], sh[8];
  ld8(Ub + (size_t)t * UC, u);
#pragma unroll
  for (int j = 0; j < 8; ++j) sh[j] = 0.f;
  float cf;
  if (path == 0) {
    if (t > 0) ld8acc(Ub + (size_t)(t - 1) * UC, sh);
    if (t < T - 1) ld8acc(Ub + (size_t)(t + 1) * UC, sh);
    cf = 0.5f;
  } else {
    if (t >= 64) ld8acc(Ub + (size_t)(t - 64) * UC, sh);
    if (t < T - 64) ld8acc(Ub + (size_t)(t + 64) * UC, sh);
    if ((t & 63) > 0) ld8acc(Ub + (size_t)(t - 1) * UC, sh);
    if ((t & 63) < 63) ld8acc(Ub + (size_t)(t + 1) * UC, sh);
    cf = 0.25f;
  }
#pragma unroll
  for (int j = 0; j < 8; ++j) blk[j] = u[j] + mu[j] * (sh[j] * cf - u[j]);
}

__device__ void phase_mod(const Params& p, int wv) {
  float* smem = SMEM;
  const int tid = opaque_tid(wv);
  if (blockIdx.x == 0 && tid < 8) p.ctr[tid] = 0u;
  if (PROBE_SEL && blockIdx.x == 0 && tid < 64) p.ts[tid] = 0ull;
  for (int idx = blockIdx.x * NTHREADS + tid; idx < 24576 + 16384; idx += gridDim.x * NTHREADS) {
    float f[8];
    if (idx < 24576) {
      const int ln = idx & 63, fr = (idx >> 6) & 7, mat = (idx >> 9) & 1, hd = idx >> 10;
      const int h = hd % 6, ld = hd / 6, nt = fr >> 1, ks = fr & 1;
      const float* src = mat ? p.r_a2 : p.r_w2;
#pragma unroll
      for (int j = 0; j < 8; ++j) f[j] = src[((size_t)ld * 64 + 8 * (ln >> 4) + j + 32 * ks) * 384 + h * 64 + nt * 16 + (ln & 15)];
      *(uint4*)(p.WF + (size_t)idx * 8) = pack8(f);
    } else {
      const int id2 = idx - 24576;
      const int ln = id2 & 63, fr = (id2 >> 6) & 7, mat = (id2 >> 9) & 1, ldn = id2 >> 10;
      const int nt = fr >> 1, ks = fr & 1;
      const float* src = mat ? p.l_wx : p.l_wa;
#pragma unroll
      for (int j = 0; j < 8; ++j) f[j] = src[((size_t)ldn * 64 + 8 * (ln >> 4) + j + 32 * ks) * 64 + nt * 16 + (ln & 15)];
      *(uint4*)(p.LF + (size_t)id2 * 8) = pack8(f);
    }
  }
  for (int i = tid; i < 9 * 1024; i += NTHREADS) {
    int v = i >> 10, k = i & 1023;
    float cv = (v == 0) ? p.c_ctx[k] : p.c[(v - 1) * 1024 + k];
    smem[i] = siluf(cv);
  }
  __syncthreads();
  float* red = smem + 9 * 1024;
  const int col = tid & 31, kg = tid >> 5;
  for (int chunk = blockIdx.x; chunk < 192; chunk += gridDim.x) {
    const int l = chunk / 96, n0 = (chunk % 96) * 32;
    const float* w = p.w_mod + (size_t)l * 1024 * 3072 + n0 + col;
    float acc[9];
#pragma unroll
    for (int v = 0; v < 9; ++v) acc[v] = 0.f;
    for (int k = kg * 64; k < kg * 64 + 64; ++k) {
      float wv = w[(size_t)k * 3072];
#pragma unroll
      for (int v = 0; v < 9; ++v) acc[v] += smem[v * 1024 + k] * wv;
    }
#pragma unroll
    for (int v = 0; v < 9; ++v) red[(kg * 9 + v) * 32 + col] = acc[v];
    __syncthreads();
    if (tid < 288) {
      int v = tid >> 5;
      float s = 0.f;
      for (int g = 0; g < 16; ++g) s += red[(g * 9 + v) * 32 + col];
      p.MOD[(size_t)(l * 9 + v) * 3072 + n0 + col] = s + p.b_mod[l * 3072 + n0 + col];
    }
    __syncthreads();
  }
}

__device__ __forceinline__ int modvec(int row) { return row < NTP ? 0 : 1 + ((row - NTP) >> 11); }

__device__ void phase_h0(const Params& p, int wv) {
  const int tid = opaque_tid(wv);
  const int wave = tid >> 6, lane = tid & 63;
  for (int row = blockIdx.x * 8 + wave; row < NTOK; row += gridDim.x * 8) {
    const float* xr = row < NTP ? p.x_prompt + (size_t)row * DM : p.x_sample + (size_t)(row - NTP) * DM;
    float4 v[4];
    float ss = 0.f;
#pragma unroll
    for (int j = 0; j < 4; ++j) {
      v[j] = ((const float4*)xr)[lane + 64 * j];
      ss += v[j].x * v[j].x + v[j].y * v[j].y + v[j].z * v[j].z + v[j].w * v[j].w;
    }
    ss += shx<1>(ss); ss += shx<2>(ss); ss += shx<4>(ss); ss += shx<8>(ss); ss += shx<16>(ss);
    ss = __builtin_amdgcn_readlane(ss, 0) + __builtin_amdgcn_readlane(ss, 32);
    const float rstd = rsqrtf(ss * (1.f / 1024.f) + EPSF);
    const float* md = p.MOD + (size_t)modvec(row) * 3072;
#pragma unroll
    for (int j = 0; j < 4; ++j) {
      const int k = (lane + 64 * j) * 4;
      float4 g = *(const float4*)(p.g_pre + k);
      float4 sh = *(const float4*)(md + k);
      float4 sc = *(const float4*)(md + 1024 + k);
      uint2 o;
      o.x = pack2(v[j].x * rstd * g.x * (1.f + sc.x) + sh.x, v[j].y * rstd * g.y * (1.f + sc.y) + sh.y);
      o.y = pack2(v[j].z * rstd * g.z * (1.f + sc.z) + sh.z, v[j].w * rstd * g.w * (1.f + sc.w) + sh.w);
      *(uint2*)(p.HM + (size_t)row * DM + k) = o;
    }
  }
}

#define LDK 40
__device__ __forceinline__ int ldsrow(int n) { return (n & ~63) | ((n & 3) << 4) | ((n >> 2) & 15); }

template <int BM, int BN, int WM, int WN, bool PREF>
__device__ __forceinline__ void gemm_mainloop(const bfu* __restrict__ A, const float* __restrict__ B, int ldb, int n0,
                                              int nvalid, bfu* As, bfu* Bs, f32x4 (&acc)[BM / WM / 16][BN / WN / 16], const int tid) {
  constexpr int TM = BM / WM / 16, TN = BN / WN / 16;
  constexpr int NA = (BM * 4 + NTHREADS - 1) / NTHREADS;
  constexpr int NB = BN * 4 / NTHREADS;
  constexpr int NBH = PREF ? NB : 2;
  const int wave = tid >> 6, lane = tid & 63;
  const int wm = wave / WN, wn = wave % WN;
  const int mbase = wm * (BM / WM), nbase = wn * (BN / WN);
#pragma unroll
  for (int i = 0; i < TM; ++i)
#pragma unroll
    for (int j = 0; j < TN; ++j) acc[i][j] = (f32x4){0.f, 0.f, 0.f, 0.f};

  const __amdgpu_buffer_rsrc_t rsrc = __builtin_amdgcn_make_buffer_rsrc((void*)B, 0, 1024 * ldb * 4, 0x00020000);
  uint4 ra[NA];
  float rb[NBH][8];
#pragma unroll
  for (int j = 0; j < NA; ++j) ra[j] = make_uint4(0u, 0u, 0u, 0u);

#define G_LOADA(ks_)                                                                                        \
  _Pragma("unroll") for (int j = 0; j < NA; ++j) {                                                          \
    const int c = tid + NTHREADS * j;                                                                       \
    if (c < BM * 4) ra[j] = *(const uint4*)(A + (size_t)(c >> 2) * DM + (ks_) * 32 + (c & 3) * 8);          \
  }
#define G_STOREA()                                                                                          \
  _Pragma("unroll") for (int j = 0; j < NA; ++j) {                                                          \
    const int c = tid + NTHREADS * j;                                                                       \
    if (c < BM * 4) *(uint4*)(As + (c >> 2) * LDK + (c & 3) * 8) = ra[j];                                   \
  }
#define G_LOADB(ks_, j0_)                                                                                   \
  _Pragma("unroll") for (int j = 0; j < NBH; ++j) {                                                         \
    const int u = tid + NTHREADS * (j + (j0_));                                                             \
    const int n = u % BN, kg = u / BN;                                                                      \
    const unsigned voff = (n < nvalid) ? (unsigned)((kg * 8 * ldb + n0 + n) * 4) : 0x80000000u;             \
    _Pragma("unroll") for (int jj = 0; jj < 8; ++jj) rb[j][jj] = __builtin_bit_cast(                        \
        float, __builtin_amdgcn_raw_buffer_load_b32(rsrc, voff, (unsigned)(((ks_) * 32 + jj) * ldb * 4), 0)); \
  }
#define G_STOREB(j0_)                                                                                       \
  _Pragma("unroll") for (int j = 0; j < NBH; ++j) {                                                         \
    const int u = tid + NTHREADS * (j + (j0_));                                                             \
    const int n = u % BN, kg = u / BN;                                                                      \
    uint4 pk;                                                                                               \
    pk.x = pack2(rb[j][0], rb[j][1]); pk.y = pack2(rb[j][2], rb[j][3]);                                     \
    pk.z = pack2(rb[j][4], rb[j][5]); pk.w = pack2(rb[j][6], rb[j][7]);                                     \
    *(uint4*)(Bs + ldsrow(n) * LDK + kg * 8) = pk;                                                          \
  }

  if (PREF) {
    G_LOADA(0)
    G_LOADB(0, 0)
  }
#pragma unroll 1
  for (int ks = 0; ks < 32; ++ks) {
    if (PREF) {
      G_STOREA()
      G_STOREB(0)
    } else {
      G_LOADA(ks)
      G_STOREA()
#pragma unroll 1
      for (int j0 = 0; j0 < NB; j0 += NBH) {
        G_LOADB(ks, j0)
        G_STOREB(j0)
      }
    }
    __syncthreads();
    if (PREF && ks + 1 < 32) {
      G_LOADA(ks + 1)
      G_LOADB(ks + 1, 0)
    }
    bf16x8 af[TM];
#pragma unroll
    for (int i = 0; i < TM; ++i) af[i] = *(const bf16x8*)(As + (mbase + i * 16 + (lane & 15)) * LDK + (lane >> 4) * 8);
#pragma unroll
    for (int j = 0; j < TN; ++j) {
      const bf16x8 bfr = *(const bf16x8*)(Bs + (nbase + j * 16 + (lane & 15)) * LDK + (lane >> 4) * 8);
#pragma unroll
      for (int i = 0; i < TM; ++i) acc[i][j] = __builtin_amdgcn_mfma_f32_16x16x32_bf16(af[i], bfr, acc[i][j], 0, 0, 0);
    }
    __syncthreads();
  }
#undef G_LOADA
#undef G_STOREA
#undef G_LOADB
#undef G_STOREB
}

__device__ void phase_inproj(const Params& p, int l, int wv) {
  float* smem = SMEM;
  bfu* As = (bfu*)smem;
  bfu* Bs = As + 256 * LDK;
  const int tid = opaque_tid(wv);
  const int wave = tid >> 6, lane = tid & 63;
  const int wm = wave >> 2, wn = wave & 3;
  for (int tile = blockIdx.x; tile < 96 * 17; tile += gridDim.x) {
    const int m0 = (tile / 17) * 256, n0 = (tile % 17) * 256;
    const int nvalid = min(256, UC - n0);
    f32x4 acc[8][4];
    gemm_mainloop<256, 256, 2, 4, true>(p.HM + (size_t)m0 * DM, p.w_in + (size_t)l * DM * UC, UC, n0, nvalid, As, Bs, acc, tid);
    const int slot = lane & 15, g4 = lane >> 4;
    const int c = n0 + wn * 64 + 4 * slot;
    if (c < UC) {
#pragma unroll
      for (int mt = 0; mt < 8; ++mt)
#pragma unroll
        for (int i = 0; i < 4; ++i) {
          const int row = m0 + wm * 128 + mt * 16 + 4 * g4 + i;
          uint2 o;
          o.x = pack2(acc[mt][0][i], acc[mt][1][i]);
          o.y = pack2(acc[mt][2][i], acc[mt][3][i]);
          *(uint2*)(p.U + (size_t)row * UC + c) = o;
        }
    }
  }
}

__device__ void phase_outproj(const Params& p, int l, int wv) {
  float* smem = SMEM;
  bfu* As = (bfu*)smem;
  bfu* Bs = As + 32 * LDK;
  float* red = (float*)(Bs + 1024 * LDK);
  float* rs = red + 256;
  const int tid = opaque_tid(wv);
  const int wave = tid >> 6, lane = tid & 63;
  const int slot = lane & 15, g4 = lane >> 4;
  for (int tile = blockIdx.x; tile < NTOK / 32; tile += gridDim.x) {
    const int m0 = tile * 32;
    f32x4 acc[2][8];
    gemm_mainloop<32, 1024, 1, 8, true>(p.HM + (size_t)m0 * DM, p.w_out + (size_t)l * DM * DM, DM, 0, DM, As, Bs, acc, tid);
#pragma unroll
    for (int mt = 0; mt < 2; ++mt)
#pragma unroll
      for (int i = 0; i < 4; ++i) {
        float s = 0.f;
#pragma unroll
        for (int nt = 0; nt < 8; ++nt) s += acc[mt][nt][i] * acc[mt][nt][i];
        s += shx<1>(s); s += shx<2>(s); s += shx<4>(s); s += shx<8>(s);
        if (slot == 0) red[wave * 32 + mt * 16 + 4 * g4 + i] = s;
      }
    __syncthreads();
    if (tid < 32) {
      float s = 0.f;
      for (int w = 0; w < 8; ++w) s += red[w * 32 + tid];
      rs[tid] = rsqrtf(s * (1.f / 1024.f) + EPSF);
    }
    __syncthreads();
    const int vec = modvec(m0);
    const float* md = p.MOD + (size_t)(l * 9 + vec) * 3072;
#pragma unroll
    for (int mt = 0; mt < 2; ++mt)
#pragma unroll
      for (int i = 0; i < 4; ++i) {
        const int rl = mt * 16 + 4 * g4 + i;
        const int row = m0 + rl;
        const float rstd = rs[rl];
        const float* xin = (l == 0) ? (row < NTP ? p.x_prompt + (size_t)row * DM : p.x_sample + (size_t)(row - NTP) * DM)
                                    : p.out + OUT_Y + (size_t)row * DM;
#pragma unroll
        for (int q = 0; q < 2; ++q) {
          const int c = wave * 128 + 64 * q + 4 * slot;
          float4 xi = *(const float4*)(xin + c);
          float4 gt = *(const float4*)(md + 2048 + c);
          float4 gp = *(const float4*)(p.g_post + l * DM + c);
          float4 xn;
          xn.x = xi.x + gt.x * (acc[mt][4 * q + 0][i] * rstd * gp.x);
          xn.y = xi.y + gt.y * (acc[mt][4 * q + 1][i] * rstd * gp.y);
          xn.z = xi.z + gt.z * (acc[mt][4 * q + 2][i] * rstd * gp.z);
          xn.w = xi.w + gt.w * (acc[mt][4 * q + 3][i] * rstd * gp.w);
          *(float4*)(p.out + OUT_Y + (size_t)row * DM + c) = xn;
          acc[mt][4 * q + 0][i] = xn.x; acc[mt][4 * q + 1][i] = xn.y; acc[mt][4 * q + 2][i] = xn.z; acc[mt][4 * q + 3][i] = xn.w;
        }
        __builtin_amdgcn_sched_barrier(0);
      }
    if (l == 0) {
      __syncthreads();
#pragma unroll
      for (int mt = 0; mt < 2; ++mt)
#pragma unroll
        for (int i = 0; i < 4; ++i) {
          float s = 0.f;
#pragma unroll
          for (int nt = 0; nt < 8; ++nt) s += acc[mt][nt][i] * acc[mt][nt][i];
          s += shx<1>(s); s += shx<2>(s); s += shx<4>(s); s += shx<8>(s);
          if (slot == 0) red[wave * 32 + mt * 16 + 4 * g4 + i] = s;
        }
      __syncthreads();
      if (tid < 32) {
        float s = 0.f;
        for (int w = 0; w < 8; ++w) s += red[w * 32 + tid];
        rs[tid] = rsqrtf(s * (1.f / 1024.f) + EPSF);
      }
      __syncthreads();
      const float* md1 = p.MOD + (size_t)(9 + vec) * 3072;
#pragma unroll
      for (int mt = 0; mt < 2; ++mt)
#pragma unroll
        for (int i = 0; i < 4; ++i) {
          const int rl = mt * 16 + 4 * g4 + i;
          const int row = m0 + rl;
          const float rstd = rs[rl];
#pragma unroll
          for (int q = 0; q < 2; ++q) {
            const int c = wave * 128 + 64 * q + 4 * slot;
            float4 g = *(const float4*)(p.g_pre + DM + c);
            float4 sh = *(const float4*)(md1 + c);
            float4 sc = *(const float4*)(md1 + 1024 + c);
            uint2 o;
            o.x = pack2(acc[mt][4 * q + 0][i] * rstd * g.x * (1.f + sc.x) + sh.x, acc[mt][4 * q + 1][i] * rstd * g.y * (1.f + sc.y) + sh.y);
            o.y = pack2(acc[mt][4 * q + 2][i] * rstd * g.z * (1.f + sc.z) + sh.z, acc[mt][4 * q + 3][i] * rstd * g.w * (1.f + sc.w) + sh.w);
            *(uint2*)(p.HM + (size_t)row * DM + c) = o;
          }
          __builtin_amdgcn_sched_barrier(0);
        }
    }
    __syncthreads();
  }
}

#define RS 68
#define RBUF (6 * 16 * RS + 16)
typedef float f2v __attribute__((ext_vector_type(2)));
typedef float f4v __attribute__((ext_vector_type(4)));

__device__ __forceinline__ void rwkv_prep_tile(const bfu* Ub, const float* PRM, float* buf, const bf16x8* wf, int t0, int T, int path,
                                               int dir, int h, int lane) {
  float *LR = buf, *LV = buf + 16 * RS, *LKH = buf + 32 * RS, *LW = buf + 48 * RS, *LB = buf + 64 * RS, *LKT = buf + 80 * RS;
  float* BON = buf + 96 * RS;
  const int tl = lane >> 2, c0 = (lane & 3) * 16;
  const int slot = lane & 15, g4 = lane >> 4;
  {
    const int t = t0 + tl;
    float part = 0.f;
#pragma unroll
    for (int hh = 0; hh < 2; ++hh) {
      const int cl = c0 + hh * 8;
      float rr[8], kk[8], vv[8];
      load_shift8(Ub + UR + h * 64 + cl, t, T, path, PRM + cl, rr);
      load_shift8(Ub + UR + 384 + h * 64 + cl, t, T, path, PRM + 64 + cl, kk);
      load_shift8(Ub + UR + 768 + h * 64 + cl, t, T, path, PRM + 128 + cl, vv);
      *(f4v*)(LR + tl * RS + cl) = (f4v){rr[0], rr[1], rr[2], rr[3]};
      *(f4v*)(LR + tl * RS + cl + 4) = (f4v){rr[4], rr[5], rr[6], rr[7]};
      *(f4v*)(LV + tl * RS + cl) = (f4v){vv[0], vv[1], vv[2], vv[3]};
      *(f4v*)(LV + tl * RS + cl + 4) = (f4v){vv[4], vv[5], vv[6], vv[7]};
      *(f4v*)(LKH + tl * RS + cl) = (f4v){kk[0], kk[1], kk[2], kk[3]};
      *(f4v*)(LKH + tl * RS + cl + 4) = (f4v){kk[4], kk[5], kk[6], kk[7]};
#pragma unroll
      for (int j = 0; j < 8; ++j) part += rr[j] * kk[j] * PRM[320 + cl + j];
    }
    part += shx<1>(part);
    part += shx<2>(part);
    BON[tl] = part;
  }
  {
    const int t = t0 + slot;
    bf16x8 awl[2], aal[2];
#pragma unroll
    for (int ks = 0; ks < 2; ++ks) {
      float blk[8];
      const int cw = 1152 + dir * 64 + 32 * ks + 8 * g4;
      load_shift8(Ub + UR + cw, t, T, path, PRM + 192 + 32 * ks + 8 * g4, blk);
#pragma unroll
      for (int j = 0; j < 8; ++j) awl[ks][j] = (short)f2bf(1.f - 2.f / (1.f + __expf(2.f * blk[j])));
      const int ca = 1280 + dir * 64 + 32 * ks + 8 * g4;
      load_shift8(Ub + UR + ca, t, T, path, PRM + 256 + 32 * ks + 8 * g4, blk);
#pragma unroll
      for (int j = 0; j < 8; ++j) aal[ks][j] = (short)f2bf(blk[j]);
    }
#pragma unroll
    for (int nt = 0; nt < 4; ++nt) {
      f32x4 aw = {0.f, 0.f, 0.f, 0.f}, aa = {0.f, 0.f, 0.f, 0.f};
#pragma unroll
      for (int ks = 0; ks < 2; ++ks) {
        aw = __builtin_amdgcn_mfma_f32_16x16x32_bf16(awl[ks], wf[(nt * 2 + ks) * 64], aw, 0, 0, 0);
        aa = __builtin_amdgcn_mfma_f32_16x16x32_bf16(aal[ks], wf[(8 + nt * 2 + ks) * 64], aa, 0, 0, 0);
      }
      const int col = nt * 16 + slot;
      const float w0v = PRM[576 + col];
      const float a0v = PRM[640 + col];
#pragma unroll
      for (int i = 0; i < 4; ++i) {
        const int tt = 4 * g4 + i;
        LW[tt * RS + col] = __expf(-0.6065306597126334f * sigm(w0v + aw[i]));
        LB[tt * RS + col] = sigm(a0v + aa[i]);
      }
    }
  }
  {
    float kap[16], kr[16], av[16];
    float ss = 0.f;
#pragma unroll
    for (int j4 = 0; j4 < 4; ++j4) {
      f4v k4 = *(const f4v*)(LKH + tl * RS + c0 + 4 * j4);
      f4v a4 = *(const f4v*)(LB + tl * RS + c0 + 4 * j4);
#pragma unroll
      for (int e = 0; e < 4; ++e) {
        kr[4 * j4 + e] = k4[e];
        av[4 * j4 + e] = a4[e];
        kap[4 * j4 + e] = k4[e] * PRM[384 + c0 + 4 * j4 + e];
        ss += kap[4 * j4 + e] * kap[4 * j4 + e];
      }
    }
    ss += shx<1>(ss);
    ss += shx<2>(ss);
    const float inv = 1.f / fmaxf(sqrtf(ss), 1e-12f);
#pragma unroll
    for (int j4 = 0; j4 < 4; ++j4) {
      f4v kh4, kt4, b4;
#pragma unroll
      for (int e = 0; e < 4; ++e) {
        const int j = 4 * j4 + e;
        const float kh = kap[j] * inv;
        kh4[e] = kh;
        kt4[e] = kr[j] * (1.f + (av[j] - 1.f) * PRM[448 + c0 + j]);
        b4[e] = kh * av[j];
      }
      *(f4v*)(LKH + tl * RS + c0 + 4 * j4) = kh4;
      *(f4v*)(LKT + tl * RS + c0 + 4 * j4) = kt4;
      *(f4v*)(LB + tl * RS + c0 + 4 * j4) = b4;
    }
  }
}

__device__ __forceinline__ void rwkv_finalize_tile(const bfu* Ub, bfu* Mb, const float* PRM, const float* buf, int t0, int h,
                                                   bool first_half, int lane) {
  const float *LR = buf, *LV = buf + 16 * RS, *BON = buf + 96 * RS;
  const int tl = lane >> 2, c0 = (lane & 3) * 16;
  const int t = t0 + tl;
  bfu* mp = Mb + (size_t)t * DM + c0;
  float y[16];
#pragma unroll
  for (int j4 = 0; j4 < 4; ++j4) {
    f4v v = *(const f4v*)(LR + tl * RS + c0 + 4 * j4);
    y[4 * j4] = v[0]; y[4 * j4 + 1] = v[1]; y[4 * j4 + 2] = v[2]; y[4 * j4 + 3] = v[3];
  }
  if (first_half) {
    *(uint4*)mp = pack8(y);
    *(uint4*)(mp + 8) = pack8(y + 8);
  } else {
    float pp[16], gz[16], vv[16];
    ld8(mp, pp); ld8(mp + 8, pp + 8);
    const bfu* gp = Ub + (size_t)t * UC + URZ + h * 64 + c0;
    ld8(gp, gz); ld8(gp + 8, gz + 8);
#pragma unroll
    for (int j4 = 0; j4 < 4; ++j4) {
      f4v v = *(const f4v*)(LV + tl * RS + c0 + 4 * j4);
      vv[4 * j4] = v[0]; vv[4 * j4 + 1] = v[1]; vv[4 * j4 + 2] = v[2]; vv[4 * j4 + 3] = v[3];
    }
    const float bon = BON[tl];
    float ss = 0.f;
#pragma unroll
    for (int j = 0; j < 16; ++j) { y[j] += pp[j]; ss += y[j] * y[j]; }
    ss += shx<1>(ss);
    ss += shx<2>(ss);
    const float rstd = rsqrtf(ss * (1.f / 64.f) + EPSF);
#pragma unroll
    for (int j = 0; j < 16; ++j) {
      float o = y[j] * rstd * PRM[512 + c0 + j] + bon * vv[j];
      y[j] = o * siluf(gz[j]);
    }
    *(uint4*)mp = pack8(y);
    *(uint4*)(mp + 8) = pack8(y + 8);
  }
}

__device__ void rwkv_job(const Params& p, int l, int path, int unit, int wv) {
  float* smem = SMEM;
  const int tid = opaque_tid(wv);
  const int wave = wv, lane = tid & 63;
  const int b = unit / 6, h = unit % 6;
  const int T = path ? 2048 : 256, NT = T >> 4;
  if (wave >= 4) {
#pragma unroll 1
    for (int i = 0; i < NT + 2; ++i) __syncthreads();
    return;
  }
  const int dir = wave & 1;
  const size_t tok0 = path ? (size_t)NTP + (size_t)b * 2048 : (size_t)b * 256;
  const bfu* Ub = p.U + tok0 * UC;
  float* D = smem + dir * (2 * RBUF + 704);
  float* PRM = D + 2 * RBUF;
  if (wave < 2) {
    f2v S[32];
    if (path) {
      const float* sp = p.sR + ((((size_t)(b * 2 + l) * 2 + dir) * 6 + h) * 64 + lane) * 64;
#pragma unroll
      for (int k4 = 0; k4 < 16; ++k4) {
        f4v v = ((const f4v*)sp)[k4];
        S[2 * k4] = v.xy; S[2 * k4 + 1] = v.zw;
      }
    } else {
#pragma unroll
      for (int k = 0; k < 32; ++k) S[k] = (f2v){0.f, 0.f};
    }
    __syncthreads();
#pragma unroll 1
    for (int it = 0; it <= NT; ++it) {
      if (it < NT) {
        float* buf = D + (it & 1) * RBUF;
        float *LR = buf, *LV = buf + 16 * RS;
        f4v A[8], B[8];
#define LD_H(dst, s_, hf_)                                                               \
  {                                                                                      \
    const f4v* q = (const f4v*)(buf + 32 * RS + (s_) * RS) + 8 * (hf_);                  \
    _Pragma("unroll") for (int i = 0; i < 8; ++i) dst[i] = q[i];                         \
  }
#define LD_K(dst, s_, g_)                                                                \
  {                                                                                      \
    const f4v* qw = (const f4v*)(buf + 48 * RS + (s_) * RS) + 2 * (g_);                  \
    const f4v* qb = (const f4v*)(buf + 64 * RS + (s_) * RS) + 2 * (g_);                  \
    const f4v* qk = (const f4v*)(buf + 80 * RS + (s_) * RS) + 2 * (g_);                  \
    const f4v* qr = (const f4v*)(buf + (s_) * RS) + 2 * (g_);                            \
    _Pragma("unroll") for (int i = 0; i < 2; ++i) {                                      \
      dst[4 * i] = qw[i]; dst[4 * i + 1] = qb[i]; dst[4 * i + 2] = qk[i]; dst[4 * i + 3] = qr[i]; \
    }                                                                                    \
  }
#define CP_H(src, hf_)                                                                   \
  {                                                                                      \
    _Pragma("unroll") for (int i = 0; i < 8; ++i) {                                      \
      ska = __builtin_elementwise_fma(S[2 * (8 * (hf_) + i)], src[i].xy, ska);           \
      skb = __builtin_elementwise_fma(S[2 * (8 * (hf_) + i) + 1], src[i].zw, skb);       \
    }                                                                                    \
  }
#define CP_K(src, g_)                                                                    \
  {                                                                                      \
    _Pragma("unroll") for (int i = 0; i < 2; ++i) {                                      \
      const int k4 = 2 * (g_) + i;                                                       \
      f2v t0 = vv2 * src[4 * i + 2].xy, t1 = vv2 * src[4 * i + 2].zw;                    \
      t0 = __builtin_elementwise_fma(nsk2, src[4 * i + 1].xy, t0);                       \
      t1 = __builtin_elementwise_fma(nsk2, src[4 * i + 1].zw, t1);                       \
      S[2 * k4] = __builtin_elementwise_fma(S[2 * k4], src[4 * i].xy, t0);               \
      S[2 * k4 + 1] = __builtin_elementwise_fma(S[2 * k4 + 1], src[4 * i].zw, t1);       \
      ya = __builtin_elementwise_fma(S[2 * k4], src[4 * i + 3].xy, ya);                  \
      yb = __builtin_elementwise_fma(S[2 * k4 + 1], src[4 * i + 3].zw, yb);              \
    }                                                                                    \
  }
#define SB() __builtin_amdgcn_sched_barrier(0)
        const int s0 = dir ? 15 : 0, ds = dir ? -1 : 1;
        LD_H(A, s0, 0)
        SB();
#pragma unroll 1
        for (int s_ = 0; s_ < 16; ++s_) {
          const int s = s0 + ds * s_;
          const int sn = (s_ < 15) ? s + ds : s;
          f2v ska = {0.f, 0.f}, skb = {0.f, 0.f}, ya = {0.f, 0.f}, yb = {0.f, 0.f};
          const float vv = LV[s * RS + lane];
          const f2v vv2 = {vv, vv};
          LD_H(B, s, 1) SB(); CP_H(A, 0) SB();
          LD_K(A, s, 0) SB(); CP_H(B, 1) SB();
          const float sk = (ska.x + ska.y) + (skb.x + skb.y);
          const f2v nsk2 = {-sk, -sk};
          LD_K(B, s, 1) SB(); CP_K(A, 0) SB();
          LD_K(A, s, 2) SB(); CP_K(B, 1) SB();
          LD_K(B, s, 3) SB(); CP_K(A, 2) SB();
          LD_K(A, s, 4) SB(); CP_K(B, 3) SB();
          LD_K(B, s, 5) SB(); CP_K(A, 4) SB();
          LD_K(A, s, 6) SB(); CP_K(B, 5) SB();
          LD_K(B, s, 7) SB(); CP_K(A, 6) SB();
          LD_H(A, sn, 0) SB(); CP_K(B, 7) SB();
          LR[s * RS + lane] = (ya.x + ya.y) + (yb.x + yb.y);
        }
#undef LD_H
#undef LD_K
#undef CP_H
#undef CP_K
#undef SB
      }
      __syncthreads();
    }
    if (path == 0) {
      float* op = p.out + OUT_R + ((((size_t)(b * 2 + l) * 2 + dir) * 6 + h) * 64 + lane) * 64;
#pragma unroll
      for (int k4 = 0; k4 < 16; ++k4) {
        f4v v;
        v.xy = S[2 * k4]; v.zw = S[2 * k4 + 1];
        ((f4v*)op)[k4] = v;
      }
    }
  } else {
    bfu* Mb = p.HM + tok0 * DM + 384 + h * 64;
    {
      const float* mu0 = p.r_mu + l * 1408;
      PRM[lane] = mu0[h * 64 + lane];
      PRM[64 + lane] = mu0[384 + h * 64 + lane];
      PRM[128 + lane] = mu0[768 + h * 64 + lane];
      PRM[192 + lane] = mu0[1152 + dir * 64 + lane];
      PRM[256 + lane] = mu0[1280 + dir * 64 + lane];
      PRM[320 + lane] = p.r_rk[l * 384 + h * 64 + lane];
      PRM[384 + lane] = p.r_kk[l * 384 + h * 64 + lane];
      PRM[448 + lane] = p.r_ka[l * 384 + h * 64 + lane];
      PRM[512 + lane] = p.r_norm[l * 384 + h * 64 + lane];
      PRM[576 + lane] = p.r_w0[(l * 2 + dir) * 384 + h * 64 + lane];
      PRM[640 + lane] = p.r_a0[(l * 2 + dir) * 384 + h * 64 + lane];
    }
    const bf16x8* wf = (const bf16x8*)p.WF + ((size_t)((l * 2 + dir) * 6 + h) * 16) * 64 + lane;
    rwkv_prep_tile(Ub, PRM, D, wf, (dir ? NT - 1 : 0) * 16, T, path, dir, h, lane);
    __syncthreads();
#pragma unroll 1
    for (int it = 0; it <= NT; ++it) {
      if (it >= 1) {
        const int k = it - 1;
        rwkv_finalize_tile(Ub, Mb, PRM, D + (k & 1) * RBUF, (dir ? NT - 1 - k : k) * 16, h, k < NT / 2, lane);
      }
      if (it + 1 < NT) {
        const int k = it + 1;
        rwkv_prep_tile(Ub, PRM, D + (k & 1) * RBUF, wf, (dir ? NT - 1 - k : k) * 16, T, path, dir, h, lane);
      }
      __syncthreads();
    }
  }
}

#define LS 72
__device__ void mlstm_job(const Params& p, int l, int path, int unit, int wv) {
  float* smem = SMEM;
  const int tid = opaque_tid(wv);
  const int wave = tid >> 6, lane = tid & 63;
  const int dir = wave >> 2, w = wave & 3, tg = tid & 255;
  const int b = unit / 6, h = unit % 6;
  const int T = path ? 2048 : 256, NC = T >> 6;
  const size_t tok0 = path ? (size_t)NTP + (size_t)b * 2048 : (size_t)b * 256;
  const bfu* Ub = p.U + tok0 * UC;
  bfu* Mb = p.HM + tok0 * DM + h * 64;
  bfu* base = (bfu*)smem + dir * (288 * LS);
  bfu *KWT = base, *VT = base + 64 * LS, *CT = base + 144 * LS, *P = base + 224 * LS;
  float* fb = smem + (2 * 288 * LS * 2) / 4 + dir * 272;
  float *X = fb, *MX = fb + 64, *BC = fb + 128, *WK = fb + 192, *SC = fb + 256;
  const int slot = lane & 15, g4 = lane >> 4;
  f32x4 C[5];
  float mstate = 0.f;
#pragma unroll
  for (int nt = 0; nt < 5; ++nt) C[nt] = (f32x4){0.f, 0.f, 0.f, 0.f};
  if (path) {
    const size_t sb = ((size_t)(b * 2 + l) * 2 + dir) * 6 + h;
    mstate = p.sm[sb];
#pragma unroll
    for (int nt = 0; nt < 4; ++nt)
#pragma unroll
      for (int i = 0; i < 4; ++i) C[nt][i] = p.sC[(sb * 64 + 16 * w + 4 * g4 + i) * 64 + nt * 16 + slot];
    if (slot == 0)
#pragma unroll
      for (int i = 0; i < 4; ++i) C[4][i] = p.sn[sb * 64 + 16 * w + 4 * g4 + i];
  }
  for (int i = tg; i < 16 * LS; i += 256) VT[64 * LS + i] = (i < 64) ? (bfu)0x3F80 : (bfu)0;
  const float bi = p.m_bi[l * 12 + dir * 6 + h], bff = p.m_bf[l * 12 + dir * 6 + h];
  __syncthreads();
  for (int ic = 0; ic < NC; ++ic) {
    const int ch = dir ? NC - 1 - ic : ic;
    const int c0t = ch * 64;
    if (w == 0) {
      const bfu* ur = Ub + (size_t)(c0t + lane) * UC;
      const float ip = bf2f(ur[UM_I + dir * 6 + h]) + bi;
      const float fp = bf2f(ur[UM_F + dir * 6 + h]) + bff;
      const float lf = fminf(fp, 0.f) - log1pf(__expf(-fabsf(fp)));
      float bs = lf;
      if (dir == 0) {
#pragma unroll
        for (int o = 1; o < 64; o <<= 1) { float v = bperm(lane - o, bs); if (lane >= o) bs += v; }
      } else {
#pragma unroll
        for (int o = 1; o < 64; o <<= 1) { float v = bperm(lane + o, bs); if (lane + o < 64) bs += v; }
      }
      const float x = ip - bs;
      float pm = x;
      if (dir == 0) {
#pragma unroll
        for (int o = 1; o < 64; o <<= 1) { float v = bperm(lane - o, pm); if (lane >= o) pm = fmaxf(pm, v); }
      } else {
#pragma unroll
        for (int o = 1; o < 64; o <<= 1) { float v = bperm(lane + o, pm); if (lane + o < 64) pm = fmaxf(pm, v); }
      }
      const int last = dir ? 0 : 63;
      const float pmtot = bperm(last, pm), bL = bperm(last, bs);
      const float mref = fmaxf(mstate, pmtot);
      X[lane] = x; MX[lane] = fmaxf(mstate, pm); BC[lane] = bs; WK[lane] = __expf(x - mref);
      if (lane == 0) { SC[0] = __expf(mstate - mref); SC[1] = bL + mref; }
    }
#pragma unroll
    for (int nt = 0; nt < 5; ++nt) {
      uint2 o;
      o.x = pack2(C[nt][0], C[nt][1]);
      o.y = pack2(C[nt][2], C[nt][3]);
      *(uint2*)(CT + (nt * 16 + slot) * LS + 16 * w + 4 * g4) = o;
    }
    __syncthreads();
    {
      const int s = tg >> 2, cq = (tg & 3) * 16;
      const bfu* ur = Ub + (size_t)(c0t + s) * UC + h * 64 + cq;
      float kf[16];
      ld8(ur + UM_K, kf); ld8(ur + UM_K + 8, kf + 8);
      const float sc = 0.125f * WK[s];
      const uint4 v0 = *(const uint4*)(ur + UM_V), v1 = *(const uint4*)(ur + UM_V + 8);
      const unsigned vv[8] = {v0.x, v0.y, v0.z, v0.w, v1.x, v1.y, v1.z, v1.w};
#pragma unroll
      for (int j = 0; j < 16; ++j) {
        KWT[(cq + j) * LS + s] = f2bf(kf[j] * sc);
        VT[(cq + j) * LS + s] = (bfu)((j & 1) ? (vv[j >> 1] >> 16) : (vv[j >> 1] & 0xffffu));
      }
    }
    bf16x8 aq[2];
    {
      const bfu* qp = Ub + (size_t)(c0t + 16 * w + slot) * UC + UM_Q + h * 64 + 8 * g4;
      aq[0] = *(const bf16x8*)qp;
      aq[1] = *(const bf16x8*)(qp + 32);
      f32x4 aS[4];
#pragma unroll
      for (int nt = 0; nt < 4; ++nt) {
        const bfu* kp = Ub + (size_t)(c0t + nt * 16 + slot) * UC + UM_K + h * 64 + 8 * g4;
        bf16x8 k0 = *(const bf16x8*)kp, k1 = *(const bf16x8*)(kp + 32);
        aS[nt] = (f32x4){0.f, 0.f, 0.f, 0.f};
        aS[nt] = __builtin_amdgcn_mfma_f32_16x16x32_bf16(aq[0], k0, aS[nt], 0, 0, 0);
        aS[nt] = __builtin_amdgcn_mfma_f32_16x16x32_bf16(aq[1], k1, aS[nt], 0, 0, 0);
      }
#pragma unroll
      for (int i = 0; i < 4; ++i) {
        const int t = 16 * w + 4 * g4 + i;
        const float mxt = MX[t];
#pragma unroll
        for (int nt = 0; nt < 4; ++nt) {
          const int s = nt * 16 + slot;
          const bool keep = dir ? (s >= t) : (s <= t);
          const float pv = keep ? aS[nt][i] * 0.125f * __expf(X[s] - mxt) : 0.f;
          P[t * LS + s] = f2bf(pv);
        }
      }
    }
    __syncthreads();
    f32x4 hv[4];
    {
      bf16x8 ap[2];
      const bfu* pp = P + (16 * w + slot) * LS + 8 * g4;
      ap[0] = *(const bf16x8*)pp; ap[1] = *(const bf16x8*)(pp + 32);
      f32x4 aC[5], aP[5];
#pragma unroll
      for (int nt = 0; nt < 5; ++nt) {
        aC[nt] = (f32x4){0.f, 0.f, 0.f, 0.f};
        aP[nt] = (f32x4){0.f, 0.f, 0.f, 0.f};
#pragma unroll
        for (int ks = 0; ks < 2; ++ks) {
          bf16x8 bc = *(const bf16x8*)(CT + (nt * 16 + slot) * LS + 32 * ks + 8 * g4);
          bf16x8 bv = *(const bf16x8*)(VT + (nt * 16 + slot) * LS + 32 * ks + 8 * g4);
          aC[nt] = __builtin_amdgcn_mfma_f32_16x16x32_bf16(aq[ks], bc, aC[nt], 0, 0, 0);
          aP[nt] = __builtin_amdgcn_mfma_f32_16x16x32_bf16(ap[ks], bv, aP[nt], 0, 0, 0);
        }
      }
#pragma unroll
      for (int i = 0; i < 4; ++i) {
        const int t = 16 * w + 4 * g4 + i;
        const float mxt = MX[t];
        const float sc = __expf(mstate - mxt);
        float den = sc * aC[4][i] + aP[4][i];
        den = bperm(lane & 48, den);
        const float lower = __expf(-(BC[t] + mxt));
        const float inv = 1.f / fmaxf(fabsf(den), lower);
#pragma unroll
        for (int nt = 0; nt < 4; ++nt) hv[nt][i] = (sc * aC[nt][i] + aP[nt][i]) * inv;
      }
    }
#pragma unroll
    for (int i = 0; i < 4; ++i) {
      const int t = c0t + 16 * w + 4 * g4 + i;
      bfu* mp = Mb + (size_t)t * DM;
      if (ic < NC / 2) {
#pragma unroll
        for (int nt = 0; nt < 4; ++nt) mp[nt * 16 + slot] = f2bf(hv[nt][i]);
      } else {
        float hh[4];
        float ss = 0.f;
#pragma unroll
        for (int nt = 0; nt < 4; ++nt) { hh[nt] = hv[nt][i] + bf2f(mp[nt * 16 + slot]); ss += hh[nt] * hh[nt]; }
        ss += shx<1>(ss); ss += shx<2>(ss); ss += shx<4>(ss); ss += shx<8>(ss);
        const float rstd = rsqrtf(ss * (1.f / 64.f) + EPSF);
        const bfu* ur = Ub + (size_t)t * UC + h * 64;
#pragma unroll
        for (int nt = 0; nt < 4; ++nt) {
          const int e = nt * 16 + slot;
          const float o = bf2f(ur[UM_O + e]), z = bf2f(ur[UM_Z + e]);
          mp[e] = f2bf(hh[nt] * rstd * p.m_norm[l * 384 + h * 64 + e] * sigm(o) * siluf(z));
        }
      }
    }
    {
      const float dec = SC[0];
      bf16x8 ak[2];
      const bfu* kp = KWT + (16 * w + slot) * LS + 8 * g4;
      ak[0] = *(const bf16x8*)kp; ak[1] = *(const bf16x8*)(kp + 32);
#pragma unroll
      for (int nt = 0; nt < 5; ++nt) {
        f32x4 aD = {0.f, 0.f, 0.f, 0.f};
#pragma unroll
        for (int ks = 0; ks < 2; ++ks) {
          bf16x8 bv = *(const bf16x8*)(VT + (nt * 16 + slot) * LS + 32 * ks + 8 * g4);
          aD = __builtin_amdgcn_mfma_f32_16x16x32_bf16(ak[ks], bv, aD, 0, 0, 0);
        }
#pragma unroll
        for (int i = 0; i < 4; ++i) C[nt][i] = dec * C[nt][i] + aD[i];
      }
      mstate = SC[1];
    }
    __syncthreads();
  }
  if (path == 0) {
    const size_t sb = ((size_t)(b * 2 + l) * 2 + dir) * 6 + h;
#pragma unroll
    for (int nt = 0; nt < 4; ++nt)
#pragma unroll
      for (int i = 0; i < 4; ++i) p.out[OUT_C + (sb * 64 + 16 * w + 4 * g4 + i) * 64 + nt * 16 + slot] = C[nt][i];
    if (slot == 0)
#pragma unroll
      for (int i = 0; i < 4; ++i) p.out[OUT_N + sb * 64 + 16 * w + 4 * g4 + i] = C[4][i];
    if (tg == 0) p.out[OUT_M + sb] = mstate;
  }
}

__device__ void lru_job(const Params& p, int l, int path, int unit, int wv) {
  float* smem = SMEM;
  const int tid = opaque_tid(wv);
  const int wave = tid >> 6, lane = tid & 63;
  const int dir = wave >> 2, w = wave & 3, tg = tid & 255;
  const int b = unit >> 2, n = unit & 3;
  const int T = path ? 2048 : 256, NT = T >> 6;
  const size_t tok0 = path ? (size_t)NTP + (size_t)b * 2048 : (size_t)b * 256;
  const bfu* Ub = p.U + tok0 * UC;
  bfu* Mb = p.HM + tok0 * DM + 768 + n * 64;
  unsigned char* sb_ = (unsigned char*)smem + dir * 41984;
  bfu* XC = (bfu*)sb_;
  float* AA = (float*)(sb_ + 9216);
  float* BB = AA + 4096;
  const int slot = lane & 15, g4 = lane >> 4;
  const bf16x8* lf = (const bf16x8*)p.LF + ((size_t)((l * 2 + dir) * 4 + n) * 16) * 64 + lane;
  float hstate = 0.f;
  if (path) hstate = p.sL[((size_t)(b * 2 + l) * 2 + dir) * 256 + n * 64 + lane];
  for (int it = 0; it < NT; ++it) {
    const int ti = dir ? NT - 1 - it : it;
    const int t0 = ti * 64;
    const int tl = tg >> 2, cq = (tg & 3) * 16;
    {
      const int t = t0 + tl;
      float acc[16];
#pragma unroll
      for (int j = 0; j < 16; ++j) acc[j] = p.l_conv_b[l * 256 + n * 64 + cq + j];
#pragma unroll
      for (int tap = 0; tap < 4; ++tap) {
        const int ts = t + tap - 2;
        if (ts >= 0 && ts < T) {
          float xv[16];
          const bfu* ur = Ub + (size_t)ts * UC + UL + n * 64 + cq;
          ld8(ur, xv); ld8(ur + 8, xv + 8);
#pragma unroll
          for (int j = 0; j < 16; ++j) acc[j] += xv[j] * p.l_conv[(l * 4 + tap) * 256 + n * 64 + cq + j];
        }
      }
      *(uint4*)(XC + tl * LS + cq) = pack8(acc);
      *(uint4*)(XC + tl * LS + cq + 8) = pack8(acc + 8);
    }
    __syncthreads();
    {
      bf16x8 ax[2];
      const bfu* xp = XC + (16 * w + slot) * LS + 8 * g4;
      ax[0] = *(const bf16x8*)xp; ax[1] = *(const bf16x8*)(xp + 32);
#pragma unroll
      for (int nt = 0; nt < 4; ++nt) {
        f32x4 ga = {0.f, 0.f, 0.f, 0.f}, gx = {0.f, 0.f, 0.f, 0.f};
#pragma unroll
        for (int ks = 0; ks < 2; ++ks) {
          ga = __builtin_amdgcn_mfma_f32_16x16x32_bf16(ax[ks], lf[(nt * 2 + ks) * 64], ga, 0, 0, 0);
          gx = __builtin_amdgcn_mfma_f32_16x16x32_bf16(ax[ks], lf[(8 + nt * 2 + ks) * 64], gx, 0, 0, 0);
        }
        const int o = nt * 16 + slot;
        const int chn = (l * 2 + dir) * 256 + n * 64 + o;
        const float bav = p.l_ba[chn], bxv = p.l_bx[chn];
        const float lam = p.l_lambda[chn];
        const float sp = fmaxf(-lam, 0.f) + log1pf(__expf(-fabsf(lam)));
#pragma unroll
        for (int i = 0; i < 4; ++i) {
          const int t = 16 * w + 4 * g4 + i;
          const float rg = sigm(ga[i] + bav), ig = sigm(gx[i] + bxv);
          const float la = -8.f * rg * sp;
          const float a = __expf(la);
          const float bt = sqrtf(fmaxf(-expm1f(2.f * la), 0.f)) * ig * bf2f(XC[t * LS + o]);
          AA[t * 64 + o] = a;
          BB[t * 64 + o] = bt;
        }
      }
    }
    __syncthreads();
    if (w == 0) {
#pragma unroll 4
      for (int s_ = 0; s_ < 64; ++s_) {
        const int s = dir ? 63 - s_ : s_;
        hstate = AA[s * 64 + lane] * hstate + BB[s * 64 + lane];
        BB[s * 64 + lane] = hstate;
      }
    }
    __syncthreads();
    {
      const int t = t0 + tl;
      bfu* mp = Mb + (size_t)t * DM + cq;
      float y[16];
#pragma unroll
      for (int j = 0; j < 16; ++j) y[j] = BB[tl * 64 + cq + j];
      if (it >= NT / 2) {
        float pp[16], gz[16];
        ld8(mp, pp); ld8(mp + 8, pp + 8);
        const bfu* gp = Ub + (size_t)t * UC + ULZ + n * 64 + cq;
        ld8(gp, gz); ld8(gp + 8, gz + 8);
#pragma unroll
        for (int j = 0; j < 16; ++j) y[j] = (y[j] + pp[j]) * siluf(gz[j]);
      }
      *(uint4*)mp = pack8(y);
      *(uint4*)(mp + 8) = pack8(y + 8);
    }
    __syncthreads();
  }
  if (path == 0 && w == 0) p.out[OUT_L + ((size_t)(b * 2 + l) * 2 + dir) * 256 + n * 64 + lane] = hstate;
}

__device__ void phase_mix(const Params& p, int l, int wv) {
  __shared__ int sjob;
  for (;;) {
    if (wv == 0 && opaque_tid(0) == 0) sjob = (int)atomicAdd(&p.ctr[l], 1u);
    __syncthreads();
    const int job = __builtin_amdgcn_readfirstlane(sjob);
    __syncthreads();
    if (job >= 640) break;
    int type, path, idx;
    if (job < 48) { type = 0; path = 1; idx = job; }
    else if (job < 96) { type = 1; path = 1; idx = job - 48; }
    else if (job < 128) { type = 2; path = 1; idx = job - 96; }
    else if (job < 320) { type = 0; path = 0; idx = job - 128; }
    else if (job < 512) { type = 1; path = 0; idx = job - 320; }
    else { type = 2; path = 0; idx = job - 512; }
    if (type == 0) { if (PHM & 16) rwkv_job(p, l, path, idx, wv); }
    else if (type == 1) { if (PHM & 32) mlstm_job(p, l, path, idx, wv); }
    else { if (PHM & 64) lru_job(p, l, path, idx, wv); }
    __syncthreads();
    if (PROBE_SEL && wv == 0 && opaque_tid(0) == 0) {
      const int cat = job < 48 ? 0 : job < 96 ? 2 : job < 128 ? 3 : job < 320 ? 1 : job < 512 ? 4 : 5;
      atomicMax(&p.ts[16 + l * 8 + cat], (unsigned long long)wall_clock64());
    }
  }
}

template <bool USE_GRID>
__global__ void __launch_bounds__(NTHREADS) mega_kernel(Params p) {
  const int wv = __builtin_amdgcn_readfirstlane((int)(threadIdx.x >> 6));
  const int lo = (int)p.ph_lo, hi = (int)p.ph_hi;
  for (int ph = lo; ph < hi; ++ph) {
    if (ph == 0) { if (PHM & 1) phase_mod(p, wv); }
    else if (ph == 1) { if (PHM & 2) phase_h0(p, wv); }
    else {
      const int l = (ph - 2) / 3, s = (ph - 2) % 3;
      if (s == 0) { if (PHM & 4) phase_inproj(p, l, wv); }
      else if (s == 1) phase_mix(p, l, wv);
      else { if (PHM & 8) phase_outproj(p, l, wv); }
    }
    if constexpr (USE_GRID) {
      if (ph + 1 < hi || PROBE_SEL) cg::this_grid().sync();
    }
    if (PROBE_SEL && blockIdx.x == 0 && wv == 0 && opaque_tid(0) == 0) p.ts[ph + 1] = wall_clock64();

  }
  if (PROBE_SEL && blockIdx.x == 0 && wv == 0 && opaque_tid(0) == 0) {
    const unsigned long long tend = wall_clock64();
    unsigned long long d = 0;
    if (PROBE_SEL == 1) d = p.ts[2] - p.ts[1];
    else if (PROBE_SEL == 2) d = p.ts[3] - p.ts[2];
    else if (PROBE_SEL == 3) d = p.ts[4] - p.ts[3];
    else if (PROBE_SEL == 4) d = p.ts[5] - p.ts[4];
    else if (PROBE_SEL >= 5 && PROBE_SEL <= 10) d = p.ts[16 + PROBE_SEL - 5] - p.ts[3];
    else if (PROBE_SEL == 11) d = p.ts[8] - p.ts[7];
    while ((unsigned long long)wall_clock64() - tend < PROBE_MULT * d) asm volatile("s_sleep 2");
  }
}

extern "C" void kernel_launch(void* const* d_in, const int* in_sizes, int n_in, void* d_out, int out_size, void* d_ws,
                              size_t ws_size, hipStream_t stream) {
  static int grid = 0;
  if (grid == 0) {
    if (n_in != 34 || ws_size < WS_END) {
      fprintf(stderr, "kernel_launch: unexpected n_in %d or ws_size %zu (< %llu)\n", n_in, ws_size, WS_END);
      grid = -1;
      return;
    }
    int dev = 0, cus = 0, per_cu = 0;
    hipGetDevice(&dev);
    hipDeviceGetAttribute(&cus, hipDeviceAttributeMultiprocessorCount, dev);
#if COOP
    hipFuncSetAttribute((const void*)mega_kernel<true>, hipFuncAttributeMaxDynamicSharedMemorySize, LDS_BYTES);
    hipOccupancyMaxActiveBlocksPerMultiprocessor(&per_cu, (const void*)mega_kernel<true>, NTHREADS, LDS_BYTES);
#else
    hipFuncSetAttribute((const void*)mega_kernel<false>, hipFuncAttributeMaxDynamicSharedMemorySize, LDS_BYTES);
    hipOccupancyMaxActiveBlocksPerMultiprocessor(&per_cu, (const void*)mega_kernel<false>, NTHREADS, LDS_BYTES);
#endif
    if (per_cu < 1) { fprintf(stderr, "kernel_launch: occupancy query returned %d\n", per_cu); per_cu = 1; }
    if (per_cu > 1) per_cu = 1;
    grid = cus * per_cu;
  }
  if (grid < 0) return;
  Params p{};
  const float** pf = (const float**)&p;
  for (int i = 0; i < 34; ++i) pf[i] = (const float*)d_in[i];
  p.out = (float*)d_out;
  p.U = (bfu*)((char*)d_ws + WS_U);
  p.HM = (bfu*)((char*)d_ws + WS_HM);
  p.MOD = (float*)((char*)d_ws + WS_MOD);
  p.ctr = (unsigned int*)((char*)d_ws + WS_CTR);
  p.WF = (bfu*)((char*)d_ws + WS_WF);
  p.LF = (bfu*)((char*)d_ws + WS_LF);
  p.ts = (unsigned long long*)((char*)d_ws + WS_TS);
#if COOP
  p.ph_lo = 0; p.ph_hi = 8;
  void* args[] = {&p};
  hipError_t e = hipLaunchCooperativeKernel((const void*)mega_kernel<true>, dim3(grid), dim3(NTHREADS), args, LDS_BYTES, stream);
  if (e != hipSuccess) fprintf(stderr, "cooperative launch failed: %s (grid %d)\n", hipGetErrorString(e), grid);
#else
  for (int ph = 0; ph < 8; ++ph) {
    p.ph_lo = ph; p.ph_hi = ph + 1;
    hipLaunchKernelGGL(mega_kernel<false>, dim3(grid), dim3(NTHREADS), LDS_BYTES, stream, p);
  }
#endif
}
```

```cpp
#include <hip/hip_runtime.h>
#include <hip/hip_cooperative_groups.h>
#include <cstdio>
namespace cg = cooperative_groups;

#ifndef COOP
#define COOP 1
#endif

typedef __attribute__((ext_vector_type(8))) short bf16x8;
typedef __attribute__((ext_vector_type(4))) float f32x4;
typedef unsigned short bfu;

#define NTOK 24576
#define NTP 8192
#define DM 1024
#define UC 4248
#define EPSF 1e-6f
#define UM_Q 0
#define UM_K 384
#define UM_V 768
#define UM_O 1152
#define UM_Z 1536
#define UM_I 1920
#define UM_F 1932
#define UR 1944
#define URZ 3352
#define UL 3736
#define ULZ 3992

#define OUT_Y 0
#define OUT_C 25165824
#define OUT_N 28311552
#define OUT_M 28360704
#define OUT_R 28361472
#define OUT_L 31507200

#define WS_U 0ull
#define WS_HM 208797696ull
#define WS_MOD 259129344ull
#define WS_CTR 259350528ull
#define WS_WF 259350784ull
#define WS_LF 259744000ull
#define WS_END 260006144ull

#ifndef PHM
#define PHM 127
#endif
#ifndef PROBE_SEL
#define PROBE_SEL 0
#endif
#define PROBE_MULT 4
#define WS_TS 260006144ull
#define LDS_BYTES 116736
#define NTHREADS 512

extern __shared__ __attribute__((aligned(16))) unsigned char lds_raw[];
#define SMEM ((float*)lds_raw)

struct Params {
  const float *x_prompt, *x_sample, *c, *sC, *sn, *sm, *sR, *sL, *c_ctx, *g_pre, *g_post, *w_mod, *b_mod, *w_in, *w_out,
      *m_bi, *m_bf, *m_norm, *r_mu, *r_w0, *r_w2, *r_a0, *r_a2, *r_kk, *r_ka, *r_rk, *r_norm, *l_conv, *l_conv_b, *l_wa,
      *l_ba, *l_wx, *l_bx, *l_lambda;
  float* out;
  bfu* U;
  bfu* HM;
  float* MOD;
  unsigned int* ctr;
  bfu* WF;
  bfu* LF;
  unsigned long long* ts;
  long long ph_lo, ph_hi;
};

__device__ __forceinline__ int opaque_tid(int wv) {
  int ln = __builtin_amdgcn_mbcnt_hi(~0u, __builtin_amdgcn_mbcnt_lo(~0u, 0u));
  asm volatile("" : "+v"(ln));
  return wv * 64 + ln;
}
template <int M>
__device__ __forceinline__ float shx(float v) {
  return __builtin_bit_cast(float, __builtin_amdgcn_ds_swizzle(__builtin_bit_cast(int, v), (M << 10) | 0x1F));
}
__device__ __forceinline__ float bperm(int srclane, float v) {
  return __builtin_bit_cast(float, __builtin_amdgcn_ds_bpermute(srclane << 2, __builtin_bit_cast(int, v)));
}
__device__ __forceinline__ bfu f2bf(float f) {
  unsigned u = __float_as_uint(f);
  u += 0x7fffu + ((u >> 16) & 1u);
  return (bfu)(u >> 16);
}
__device__ __forceinline__ float bf2f(bfu h) { return __uint_as_float(((unsigned)h) << 16); }
__device__ __forceinline__ unsigned pack2(float a, float b) { return (unsigned)f2bf(a) | ((unsigned)f2bf(b) << 16); }
__device__ __forceinline__ float sigm(float x) { return 1.f / (1.f + __expf(-x)); }
__device__ __forceinline__ float siluf(float x) { return x / (1.f + __expf(-x)); }
__device__ __forceinline__ void unpack8(uint4 v, float* f) {
  f[0] = __uint_as_float(v.x << 16); f[1] = __uint_as_float(v.x & 0xffff0000u);
  f[2] = __uint_as_float(v.y << 16); f[3] = __uint_as_float(v.y & 0xffff0000u);
  f[4] = __uint_as_float(v.z << 16); f[5] = __uint_as_float(v.z & 0xffff0000u);
  f[6] = __uint_as_float(v.w << 16); f[7] = __uint_as_float(v.w & 0xffff0000u);
}
__device__ __forceinline__ void ld8(const bfu* p, float* f) { unpack8(*(const uint4*)p, f); }
__device__ __forceinline__ void ld8acc(const bfu* p, float* f) {
  float t[8]; unpack8(*(const uint4*)p, t);
#pragma unroll
  for (int j = 0; j < 8; ++j) f[j] += t[j];
}
__device__ __forceinline__ uint4 pack8(const float* f) {
  uint4 v; v.x = pack2(f[0], f[1]); v.y = pack2(f[2], f[3]); v.z = pack2(f[4], f[5]); v.w = pack2(f[6], f[7]);
  return v;
}
__device__ __forceinline__ void load_shift8(const bfu* Ub, int t, int T, int path, const float* mu, float* blk) {
  float u[8], sh[8];
  ld8(Ub + (size_t)t * UC, u);
#pragma unroll
  for (int j = 0; j < 8; ++j) sh[j] = 0.f;
  float cf;
  if (path == 0) {
    if (t > 0) ld8acc(Ub + (size_t)(t - 1) * UC, sh);
    if (t < T - 1) ld8acc(Ub + (size_t)(t + 1) * UC, sh);
    cf = 0.5f;
  } else {
    if (t >= 64) ld8acc(Ub + (size_t)(t - 64) * UC, sh);
    if (t < T - 64) ld8acc(Ub + (size_t)(t + 64) * UC, sh);
    if ((t & 63) > 0) ld8acc(Ub + (size_t)(t - 1) * UC, sh);
    if ((t & 63) < 63) ld8acc(Ub + (size_t)(t + 1) * UC, sh);
    cf = 0.25f;
  }
#pragma unroll
  for (int j = 0; j < 8; ++j) blk[j] = u[j] + mu[j] * (sh[j] * cf - u[j]);
}

__device__ void phase_mod(const Params& p, int wv) {
  float* smem = SMEM;
  const int tid = opaque_tid(wv);
  if (blockIdx.x == 0 && tid < 8) p.ctr[tid] = 0u;
  if (PROBE_SEL && blockIdx.x == 0 && tid < 64) p.ts[tid] = 0ull;
  for (int idx = blockIdx.x * NTHREADS + tid; idx < 24576 + 16384; idx += gridDim.x * NTHREADS) {
    float f[8];
    if (idx < 24576) {
      const int ln = idx & 63, fr = (idx >> 6) & 7, mat = (idx >> 9) & 1, hd = idx >> 10;
      const int h = hd % 6, ld = hd / 6, nt = fr >> 1, ks = fr & 1;
      const float* src = mat ? p.r_a2 : p.r_w2;
#pragma unroll
      for (int j = 0; j < 8; ++j) f[j] = src[((size_t)ld * 64 + 8 * (ln >> 4) + j + 32 * ks) * 384 + h * 64 + nt * 16 + (ln & 15)];
      *(uint4*)(p.WF + (size_t)idx * 8) = pack8(f);
    } else {
      const int id2 = idx - 24576;
      const int ln = id2 & 63, fr = (id2 >> 6) & 7, mat = (id2 >> 9) & 1, ldn = id2 >> 10;
      const int nt = fr >> 1, ks = fr & 1;
      const float* src = mat ? p.l_wx : p.l_wa;
#pragma unroll
      for (int j = 0; j < 8; ++j) f[j] = src[((size_t)ldn * 64 + 8 * (ln >> 4) + j + 32 * ks) * 64 + nt * 16 + (ln & 15)];
      *(uint4*)(p.LF + (size_t)id2 * 8) = pack8(f);
    }
  }
  for (int i = tid; i < 9 * 1024; i += NTHREADS) {
    int v = i >> 10, k = i & 1023;
    float cv = (v == 0) ? p.c_ctx[k] : p.c[(v - 1) * 1024 + k];
    smem[i] = siluf(cv);
  }
  __syncthreads();
  float* red = smem + 9 * 1024;
  const int col = tid & 31, kg = tid >> 5;
  for (int chunk = blockIdx.x; chunk < 192; chunk += gridDim.x) {
    const int l = chunk / 96, n0 = (chunk % 96) * 32;
    const float* w = p.w_mod + (size_t)l * 1024 * 3072 + n0 + col;
    float acc[9];
#pragma unroll
    for (int v = 0; v < 9; ++v) acc[v] = 0.f;
    for (int k = kg * 64; k < kg * 64 + 64; ++k) {
      float wv = w[(size_t)k * 3072];
#pragma unroll
      for (int v = 0; v < 9; ++v) acc[v] += smem[v * 1024 + k] * wv;
    }
#pragma unroll
    for (int v = 0; v < 9; ++v) red[(kg * 9 + v) * 32 + col] = acc[v];
    __syncthreads();
    if (tid < 288) {
      int v = tid >> 5;
      float s = 0.f;
      for (int g = 0; g < 16; ++g) s += red[(g * 9 + v) * 32 + col];
      p.MOD[(size_t)(l * 9 + v) * 3072 + n0 + col] = s + p.b_mod[l * 3072 + n0 + col];
    }
    __syncthreads();
  }
}

__device__ __forceinline__ int modvec(int row) { return row < NTP ? 0 : 1 + ((row - NTP) >> 11); }

__device__ void phase_h0(const Params& p, int wv) {
  const int tid = opaque_tid(wv);
  const int wave = tid >> 6, lane = tid & 63;
  for (int row = blockIdx.x * 8 + wave; row < NTOK; row += gridDim.x * 8) {
    const float* xr = row < NTP ? p.x_prompt + (size_t)row * DM : p.x_sample + (size_t)(row - NTP) * DM;
    float4 v[4];
    float ss = 0.f;
#pragma unroll
    for (int j = 0; j < 4; ++j) {
      v[j] = ((const float4*)xr)[lane + 64 * j];
      ss += v[j].x * v[j].x + v[j].y * v[j].y + v[j].z * v[j].z + v[j].w * v[j].w;
    }
    ss += shx<1>(ss); ss += shx<2>(ss); ss += shx<4>(ss); ss += shx<8>(ss); ss += shx<16>(ss);
    ss = __builtin_amdgcn_readlane(ss, 0) + __builtin_amdgcn_readlane(ss, 32);
    const float rstd = rsqrtf(ss * (1.f / 1024.f) + EPSF);
    const float* md = p.MOD + (size_t)modvec(row) * 3072;
#pragma unroll
    for (int j = 0; j < 4; ++j) {
      const int k = (lane + 64 * j) * 4;
      float4 g = *(const float4*)(p.g_pre + k);
      float4 sh = *(const float4*)(md + k);
      float4 sc = *(const float4*)(md + 1024 + k);
      uint2 o;
      o.x = pack2(v[j].x * rstd * g.x * (1.f + sc.x) + sh.x, v[j].y * rstd * g.y * (1.f + sc.y) + sh.y);
      o.y = pack2(v[j].z * rstd * g.z * (1.f + sc.z) + sh.z, v[j].w * rstd * g.w * (1.f + sc.w) + sh.w);
      *(uint2*)(p.HM + (size_t)row * DM + k) = o;
    }
  }
}

#define LDK 40
__device__ __forceinline__ int ldsrow(int n) { return (n & ~63) | ((n & 3) << 4) | ((n >> 2) & 15); }

template <int BM, int BN, int WM, int WN, bool PREF>
__device__ __forceinline__ void gemm_mainloop(const bfu* __restrict__ A, const float* __restrict__ B, int ldb, int n0,
                                              int nvalid, bfu* As, bfu* Bs, f32x4 (&acc)[BM / WM / 16][BN / WN / 16], const int tid) {
  constexpr int TM = BM / WM / 16, TN = BN / WN / 16;
  constexpr int NA = (BM * 4 + NTHREADS - 1) / NTHREADS;
  constexpr int NB = BN * 4 / NTHREADS;
  constexpr int NBH = PREF ? NB : 2;
  const int wave = tid >> 6, lane = tid & 63;
  const int wm = wave / WN, wn = wave % WN;
  const int mbase = wm * (BM / WM), nbase = wn * (BN / WN);
#pragma unroll
  for (int i = 0; i < TM; ++i)
#pragma unroll
    for (int j = 0; j < TN; ++j) acc[i][j] = (f32x4){0.f, 0.f, 0.f, 0.f};

  const __amdgpu_buffer_rsrc_t rsrc = __builtin_amdgcn_make_buffer_rsrc((void*)B, 0, 1024 * ldb * 4, 0x00020000);
  uint4 ra[NA];
  float rb[NBH][8];
#pragma unroll
  for (int j = 0; j < NA; ++j) ra[j] = make_uint4(0u, 0u, 0u, 0u);

#define G_LOADA(ks_)                                                                                        \
  _Pragma("unroll") for (int j = 0; j < NA; ++j) {                                                          \
    const int c = tid + NTHREADS * j;                                                                       \
    if (c < BM * 4) ra[j] = *(const uint4*)(A + (size_t)(c >> 2) * DM + (ks_) * 32 + (c & 3) * 8);          \
  }
#define G_STOREA()                                                                                          \
  _Pragma("unroll") for (int j = 0; j < NA; ++j) {                                                          \
    const int c = tid + NTHREADS * j;                                                                       \
    if (c < BM * 4) *(uint4*)(As + (c >> 2) * LDK + (c & 3) * 8) = ra[j];                                   \
  }
#define G_LOADB(ks_, j0_)                                                                                   \
  _Pragma("unroll") for (int j = 0; j < NBH; ++j) {                                                         \
    const int u = tid + NTHREADS * (j + (j0_));                                                             \
    const int n = u % BN, kg = u / BN;                                                                      \
    const unsigned voff = (n < nvalid) ? (unsigned)((kg * 8 * ldb + n0 + n) * 4) : 0x80000000u;             \
    _Pragma("unroll") for (int jj = 0; jj < 8; ++jj) rb[j][jj] = __builtin_bit_cast(                        \
        float, __builtin_amdgcn_raw_buffer_load_b32(rsrc, voff, (unsigned)(((ks_) * 32 + jj) * ldb * 4), 0)); \
  }
#define G_STOREB(j0_)                                                                                       \
  _Pragma("unroll") for (int j = 0; j < NBH; ++j) {                                                         \
    const int u = tid + NTHREADS * (j + (j0_));                                                             \
    const int n = u % BN, kg = u / BN;                                                                      \
    uint4 pk;                                                                                               \
    pk.x = pack2(rb[j][0], rb[j][1]); pk.y = pack2(rb[j][2], rb[j][3]);                                     \
    pk.z = pack2(rb[j][4], rb[j][5]); pk.w = pack2(rb[j][6], rb[j][7]);                                     \
    *(uint4*)(Bs + ldsrow(n) * LDK + kg * 8) = pk;                                                          \
  }

  if (PREF) {
    G_LOADA(0)
    G_LOADB(0, 0)
  }
#pragma unroll 1
  for (int ks = 0; ks < 32; ++ks) {
    if (PREF) {
      G_STOREA()
      G_STOREB(0)
    } else {
      G_LOADA(ks)
      G_STOREA()
#pragma unroll 1
      for (int j0 = 0; j0 < NB; j0 += NBH) {
        G_LOADB(ks, j0)
        G_STOREB(j0)
      }
    }
    __syncthreads();
    if (PREF && ks + 1 < 32) {
      G_LOADA(ks + 1)
      G_LOADB(ks + 1, 0)
    }
    bf16x8 af[TM];
#pragma unroll
    for (int i = 0; i < TM; ++i) af[i] = *(const bf16x8*)(As + (mbase + i * 16 + (lane & 15)) * LDK + (lane >> 4) * 8);
#pragma unroll
    for (int j = 0; j < TN; ++j) {
      const bf16x8 bfr = *(const bf16x8*)(Bs + (nbase + j * 16 + (lane & 15)) * LDK + (lane >> 4) * 8);
#pragma unroll
      for (int i = 0; i < TM; ++i) acc[i][j] = __builtin_amdgcn_mfma_f32_16x16x32_bf16(af[i], bfr, acc[i][j], 0, 0, 0);
    }
    __syncthreads();
  }
#undef G_LOADA
#undef G_STOREA
#undef G_LOADB
#undef G_STOREB
}

__device__ void phase_inproj(const Params& p, int l, int wv) {
  float* smem = SMEM;
  bfu* As = (bfu*)smem;
  bfu* Bs = As + 256 * LDK;
  const int tid = opaque_tid(wv);
  const int wave = tid >> 6, lane = tid & 63;
  const int wm = wave >> 2, wn = wave & 3;
  for (int tile = blockIdx.x; tile < 96 * 17; tile += gridDim.x) {
    const int m0 = (tile / 17) * 256, n0 = (tile % 17) * 256;
    const int nvalid = min(256, UC - n0);
    f32x4 acc[8][4];
    gemm_mainloop<256, 256, 2, 4, true>(p.HM + (size_t)m0 * DM, p.w_in + (size_t)l * DM * UC, UC, n0, nvalid, As, Bs, acc, tid);
    const int slot = lane & 15, g4 = lane >> 4;
    const int c = n0 + wn * 64 + 4 * slot;
    if (c < UC) {
#pragma unroll
      for (int mt = 0; mt < 8; ++mt)
#pragma unroll
        for (int i = 0; i < 4; ++i) {
          const int row = m0 + wm * 128 + mt * 16 + 4 * g4 + i;
          uint2 o;
          o.x = pack2(acc[mt][0][i], acc[mt][1][i]);
          o.y = pack2(acc[mt][2][i], acc[mt][3][i]);
          *(uint2*)(p.U + (size_t)row * UC + c) = o;
        }
    }
  }
}

__device__ void phase_outproj(const Params& p, int l, int wv) {
  float* smem = SMEM;
  bfu* As = (bfu*)smem;
  bfu* Bs = As + 32 * LDK;
  float* red = (float*)(Bs + 1024 * LDK);
  float* rs = red + 256;
  const int tid = opaque_tid(wv);
  const int wave = tid >> 6, lane = tid & 63;
  const int slot = lane & 15, g4 = lane >> 4;
  for (int tile = blockIdx.x; tile < NTOK / 32; tile += gridDim.x) {
    const int m0 = tile * 32;
    f32x4 acc[2][8];
    gemm_mainloop<32, 1024, 1, 8, true>(p.HM + (size_t)m0 * DM, p.w_out + (size_t)l * DM * DM, DM, 0, DM, As, Bs, acc, tid);
#pragma unroll
    for (int mt = 0; mt < 2; ++mt)
#pragma unroll
      for (int i = 0; i < 4; ++i) {
        float s = 0.f;
#pragma unroll
        for (int nt = 0; nt < 8; ++nt) s += acc[mt][nt][i] * acc[mt][nt][i];
        s += shx<1>(s); s += shx<2>(s); s += shx<4>(s); s += shx<8>(s);
        if (slot == 0) red[wave * 32 + mt * 16 + 4 * g4 + i] = s;
      }
    __syncthreads();
    if (tid < 32) {
      float s = 0.f;
      for (int w = 0; w < 8; ++w) s += red[w * 32 + tid];
      rs[tid] = rsqrtf(s * (1.f / 1024.f) + EPSF);
    }
    __syncthreads();
    const int vec = modvec(m0);
    const float* md = p.MOD + (size_t)(l * 9 + vec) * 3072;
#pragma unroll
    for (int mt = 0; mt < 2; ++mt)
#pragma unroll
      for (int i = 0; i < 4; ++i) {
        const int rl = mt * 16 + 4 * g4 + i;
        const int row = m0 + rl;
        const float rstd = rs[rl];
        const float* xin = (l == 0) ? (row < NTP ? p.x_prompt + (size_t)row * DM : p.x_sample + (size_t)(row - NTP) * DM)
                                    : p.out + OUT_Y + (size_t)row * DM;
#pragma unroll
        for (int q = 0; q < 2; ++q) {
          const int c = wave * 128 + 64 * q + 4 * slot;
          float4 xi = *(const float4*)(xin + c);
          float4 gt = *(const float4*)(md + 2048 + c);
          float4 gp = *(const float4*)(p.g_post + l * DM + c);
          float4 xn;
          xn.x = xi.x + gt.x * (acc[mt][4 * q + 0][i] * rstd * gp.x);
          xn.y = xi.y + gt.y * (acc[mt][4 * q + 1][i] * rstd * gp.y);
          xn.z = xi.z + gt.z * (acc[mt][4 * q + 2][i] * rstd * gp.z);
          xn.w = xi.w + gt.w * (acc[mt][4 * q + 3][i] * rstd * gp.w);
          *(float4*)(p.out + OUT_Y + (size_t)row * DM + c) = xn;
          acc[mt][4 * q + 0][i] = xn.x; acc[mt][4 * q + 1][i] = xn.y; acc[mt][4 * q + 2][i] = xn.z; acc[mt][4 * q + 3][i] = xn.w;
        }
        __builtin_amdgcn_sched_barrier(0);
      }
    if (l == 0) {
      __syncthreads();
#pragma unroll
      for (int mt = 0; mt < 2; ++mt)
#pragma unroll
        for (int i = 0; i < 4; ++i) {
          float s = 0.f;
#pragma unroll
          for (int nt = 0; nt < 8; ++nt) s += acc[mt][nt][i] * acc[mt][nt][i];
          s += shx<1>(s); s += shx<2>(s); s += shx<4>(s); s += shx<8>(s);
          if (slot == 0) red[wave * 32 + mt * 16 + 4 * g4 + i] = s;
        }
      __syncthreads();
      if (tid < 32) {
        float s = 0.f;
        for (int w = 0; w < 8; ++w) s += red[w * 32 + tid];
        rs[tid] = rsqrtf(s * (1.f / 1024.f) + EPSF);
      }
      __syncthreads();
      const float* md1 = p.MOD + (size_t)(9 + vec) * 3072;
#pragma unroll
      for (int mt = 0; mt < 2; ++mt)
#pragma unroll
        for (int i = 0; i < 4; ++i) {
          const int rl = mt * 16 + 4 * g4 + i;
          const int row = m0 + rl;
          const float rstd = rs[rl];
#pragma unroll
          for (int q = 0; q < 2; ++q) {
            const int c = wave * 128 + 64 * q + 4 * slot;
            float4 g = *(const float4*)(p.g_pre + DM + c);
            float4 sh = *(const float4*)(md1 + c);
            float4 sc = *(const float4*)(md1 + 1024 + c);
            uint2 o;
            o.x = pack2(acc[mt][4 * q + 0][i] * rstd * g.x * (1.f + sc.x) + sh.x, acc[mt][4 * q + 1][i] * rstd * g.y * (1.f + sc.y) + sh.y);
            o.y = pack2(acc[mt][4 * q + 2][i] * rstd * g.z * (1.f + sc.z) + sh.z, acc[mt][4 * q + 3][i] * rstd * g.w * (1.f + sc.w) + sh.w);
            *(uint2*)(p.HM + (size_t)row * DM + c) = o;
          }
          __builtin_amdgcn_sched_barrier(0);
        }
    }
    __syncthreads();
  }
}

#define RS 68
#define RBUF (6 * 16 * RS + 16)
typedef float f2v __attribute__((ext_vector_type(2)));
typedef float f4v __attribute__((ext_vector_type(4)));

__device__ __forceinline__ void rwkv_prepA_tile(const bfu* Ub, const float* PRM, float* buf, int t0, int T, int path, int h, int lane) {
  float *LR = buf, *LV = buf + 16 * RS;
  float* BON = buf + 96 * RS;
  const int tl = lane >> 2, c0 = (lane & 3) * 16;
  const int t = t0 + tl;
  float part = 0.f;
#pragma unroll
  for (int hh = 0; hh < 2; ++hh) {
    const int cl = c0 + hh * 8;
    float rr[8], kk[8], vv[8];
    load_shift8(Ub + UR + h * 64 + cl, t, T, path, PRM + cl, rr);
    load_shift8(Ub + UR + 384 + h * 64 + cl, t, T, path, PRM + 64 + cl, kk);
    load_shift8(Ub + UR + 768 + h * 64 + cl, t, T, path, PRM + 128 + cl, vv);
    *(f4v*)(LR + tl * RS + cl) = (f4v){rr[0], rr[1], rr[2], rr[3]};
    *(f4v*)(LR + tl * RS + cl + 4) = (f4v){rr[4], rr[5], rr[6], rr[7]};
    *(f4v*)(LV + tl * RS + cl) = (f4v){vv[0], vv[1], vv[2], vv[3]};
    *(f4v*)(LV + tl * RS + cl + 4) = (f4v){vv[4], vv[5], vv[6], vv[7]};
#pragma unroll
    for (int j = 0; j < 8; ++j) part += rr[j] * kk[j] * PRM[320 + cl + j];
  }
  part += shx<1>(part);
  part += shx<2>(part);
  BON[tl] = part;
}
__device__ __forceinline__ void rwkv_prepB_tile(const bfu* Ub, const float* PRM, float* buf, const bf16x8* wf, int t0, int T, int path,
                                                int dir, int h, int lane) {
  float *LKH = buf + 32 * RS, *LW = buf + 48 * RS, *LB = buf + 64 * RS, *LKT = buf + 80 * RS;
  const int tl = lane >> 2, c0 = (lane & 3) * 16;
  const int slot = lane & 15, g4 = lane >> 4;
  {
    const int t = t0 + slot;
    bf16x8 awl[2], aal[2];
#pragma unroll
    for (int ks = 0; ks < 2; ++ks) {
      float blk[8];
      const int cw = 1152 + dir * 64 + 32 * ks + 8 * g4;
      load_shift8(Ub + UR + cw, t, T, path, PRM + 192 + 32 * ks + 8 * g4, blk);
#pragma unroll
      for (int j = 0; j < 8; ++j) awl[ks][j] = (short)f2bf(1.f - 2.f / (1.f + __expf(2.f * blk[j])));
      const int ca = 1280 + dir * 64 + 32 * ks + 8 * g4;
      load_shift8(Ub + UR + ca, t, T, path, PRM + 256 + 32 * ks + 8 * g4, blk);
#pragma unroll
      for (int j = 0; j < 8; ++j) aal[ks][j] = (short)f2bf(blk[j]);
    }
#pragma unroll
    for (int nt = 0; nt < 4; ++nt) {
      f32x4 aw = {0.f, 0.f, 0.f, 0.f}, aa = {0.f, 0.f, 0.f, 0.f};
#pragma unroll
      for (int ks = 0; ks < 2; ++ks) {
        aw = __builtin_amdgcn_mfma_f32_16x16x32_bf16(awl[ks], wf[(nt * 2 + ks) * 64], aw, 0, 0, 0);
        aa = __builtin_amdgcn_mfma_f32_16x16x32_bf16(aal[ks], wf[(8 + nt * 2 + ks) * 64], aa, 0, 0, 0);
      }
      const int col = nt * 16 + slot;
      const float w0v = PRM[576 + col];
      const float a0v = PRM[640 + col];
#pragma unroll
      for (int i = 0; i < 4; ++i) {
        const int tt = 4 * g4 + i;
        LW[tt * RS + col] = __expf(-0.6065306597126334f * sigm(w0v + aw[i]));
        LB[tt * RS + col] = sigm(a0v + aa[i]);
      }
    }
  }
  {
    const int t = t0 + tl;
    float kr[16], kap[16];
    load_shift8(Ub + UR + 384 + h * 64 + c0, t, T, path, PRM + 64 + c0, kr);
    load_shift8(Ub + UR + 384 + h * 64 + c0 + 8, t, T, path, PRM + 64 + c0 + 8, kr + 8);
    float ss = 0.f;
#pragma unroll
    for (int j = 0; j < 16; ++j) { kap[j] = kr[j] * PRM[384 + c0 + j]; ss += kap[j] * kap[j]; }
    ss += shx<1>(ss);
    ss += shx<2>(ss);
    const float inv = 1.f / fmaxf(sqrtf(ss), 1e-12f);
#pragma unroll
    for (int j4 = 0; j4 < 4; ++j4) {
      const f4v a4 = *(const f4v*)(LB + tl * RS + c0 + 4 * j4);
      f4v kh4, kt4, b4;
#pragma unroll
      for (int e = 0; e < 4; ++e) {
        const int j = 4 * j4 + e;
        const float kh = kap[j] * inv;
        kh4[e] = kh;
        kt4[e] = kr[j] * (1.f + (a4[e] - 1.f) * PRM[448 + c0 + j]);
        b4[e] = kh * a4[e];
      }
      *(f4v*)(LKH + tl * RS + c0 + 4 * j4) = kh4;
      *(f4v*)(LKT + tl * RS + c0 + 4 * j4) = kt4;
      *(f4v*)(LB + tl * RS + c0 + 4 * j4) = b4;
    }
  }
}

__device__ __forceinline__ void rwkv_finalize_tile(const bfu* Ub, bfu* Mb, const float* PRM, const float* buf, int t0, int h,
                                                   bool first_half, int lane) {
  const float *LR = buf, *LV = buf + 16 * RS, *BON = buf + 96 * RS;
  const int tl = lane >> 2, c0 = (lane & 3) * 16;
  const int t = t0 + tl;
  bfu* mp = Mb + (size_t)t * DM + c0;
  float y[16];
#pragma unroll
  for (int j4 = 0; j4 < 4; ++j4) {
    f4v v = *(const f4v*)(LR + tl * RS + c0 + 4 * j4);
    y[4 * j4] = v[0]; y[4 * j4 + 1] = v[1]; y[4 * j4 + 2] = v[2]; y[4 * j4 + 3] = v[3];
  }
  if (first_half) {
    *(uint4*)mp = pack8(y);
    *(uint4*)(mp + 8) = pack8(y + 8);
  } else {
    float pp[16], gz[16], vv[16];
    ld8(mp, pp); ld8(mp + 8, pp + 8);
    const bfu* gp = Ub + (size_t)t * UC + URZ + h * 64 + c0;
    ld8(gp, gz); ld8(gp + 8, gz + 8);
#pragma unroll
    for (int j4 = 0; j4 < 4; ++j4) {
      f4v v = *(const f4v*)(LV + tl * RS + c0 + 4 * j4);
      vv[4 * j4] = v[0]; vv[4 * j4 + 1] = v[1]; vv[4 * j4 + 2] = v[2]; vv[4 * j4 + 3] = v[3];
    }
    const float bon = BON[tl];
    float ss = 0.f;
#pragma unroll
    for (int j = 0; j < 16; ++j) { y[j] += pp[j]; ss += y[j] * y[j]; }
    ss += shx<1>(ss);
    ss += shx<2>(ss);
    const float rstd = rsqrtf(ss * (1.f / 64.f) + EPSF);
#pragma unroll
    for (int j = 0; j < 16; ++j) {
      float o = y[j] * rstd * PRM[512 + c0 + j] + bon * vv[j];
      y[j] = o * siluf(gz[j]);
    }
    *(uint4*)mp = pack8(y);
    *(uint4*)(mp + 8) = pack8(y + 8);
  }
}

__device__ void rwkv_job(const Params& p, int l, int path, int unit, int wv) {
  float* smem = SMEM;
  const int tid = opaque_tid(wv);
  const int wave = wv, lane = tid & 63;
  const int b = unit / 6, h = unit % 6;
  const int T = path ? 2048 : 256, NT = T >> 4;
  if (wave == 4 || wave == 5) {
#pragma unroll 1
    for (int i = 0; i < NT + 2; ++i) __syncthreads();
    return;
  }
  const int dir = wave & 1;
  const size_t tok0 = path ? (size_t)NTP + (size_t)b * 2048 : (size_t)b * 256;
  const bfu* Ub = p.U + tok0 * UC;
  float* D = smem + dir * (2 * RBUF + 1408);
  float* PRM = D + 2 * RBUF + (wave >= 6 ? 704 : 0);
  if (wave < 2) {
    f2v S[32];
    if (path) {
      const float* sp = p.sR + ((((size_t)(b * 2 + l) * 2 + dir) * 6 + h) * 64 + lane) * 64;
#pragma unroll
      for (int k4 = 0; k4 < 16; ++k4) {
        f4v v = ((const f4v*)sp)[k4];
        S[2 * k4] = v.xy; S[2 * k4 + 1] = v.zw;
      }
    } else {
#pragma unroll
      for (int k = 0; k < 32; ++k) S[k] = (f2v){0.f, 0.f};
    }
    __syncthreads();
#pragma unroll 1
    for (int it = 0; it <= NT; ++it) {
      if (it < NT) {
        float* buf = D + (it & 1) * RBUF;
        float *LR = buf, *LV = buf + 16 * RS;
        f4v A[8], B[8];
#define LD_H(dst, s_, hf_)                                                               \
  {                                                                                      \
    const f4v* q = (const f4v*)(buf + 32 * RS + (s_) * RS) + 8 * (hf_);                  \
    _Pragma("unroll") for (int i = 0; i < 8; ++i) dst[i] = q[i];                         \
  }
#define LD_K(dst, s_, g_)                                                                \
  {                                                                                      \
    const f4v* qw = (const f4v*)(buf + 48 * RS + (s_) * RS) + 2 * (g_);                  \
    const f4v* qb = (const f4v*)(buf + 64 * RS + (s_) * RS) + 2 * (g_);                  \
    const f4v* qk = (const f4v*)(buf + 80 * RS + (s_) * RS) + 2 * (g_);                  \
    const f4v* qr = (const f4v*)(buf + (s_) * RS) + 2 * (g_);                            \
    _Pragma("unroll") for (int i = 0; i < 2; ++i) {                                      \
      dst[4 * i] = qw[i]; dst[4 * i + 1] = qb[i]; dst[4 * i + 2] = qk[i]; dst[4 * i + 3] = qr[i]; \
    }                                                                                    \
  }
#define CP_H(src, hf_)                                                                   \
  {                                                                                      \
    _Pragma("unroll") for (int i = 0; i < 8; ++i) {                                      \
      ska = __builtin_elementwise_fma(S[2 * (8 * (hf_) + i)], src[i].xy, ska);           \
      skb = __builtin_elementwise_fma(S[2 * (8 * (hf_) + i) + 1], src[i].zw, skb);       \
    }                                                                                    \
  }
#define CP_K(src, g_)                                                                    \
  {                                                                                      \
    _Pragma("unroll") for (int i = 0; i < 2; ++i) {                                      \
      const int k4 = 2 * (g_) + i;                                                       \
      f2v t0 = vv2 * src[4 * i + 2].xy, t1 = vv2 * src[4 * i + 2].zw;                    \
      t0 = __builtin_elementwise_fma(nsk2, src[4 * i + 1].xy, t0);                       \
      t1 = __builtin_elementwise_fma(nsk2, src[4 * i + 1].zw, t1);                       \
      S[2 * k4] = __builtin_elementwise_fma(S[2 * k4], src[4 * i].xy, t0);               \
      S[2 * k4 + 1] = __builtin_elementwise_fma(S[2 * k4 + 1], src[4 * i].zw, t1);       \
      ya = __builtin_elementwise_fma(S[2 * k4], src[4 * i + 3].xy, ya);                  \
      yb = __builtin_elementwise_fma(S[2 * k4 + 1], src[4 * i + 3].zw, yb);              \
    }                                                                                    \
  }
#define SB() __builtin_amdgcn_sched_barrier(0)
        const int s0 = dir ? 15 : 0, ds = dir ? -1 : 1;
        LD_H(A, s0, 0)
        SB();
#pragma unroll 1
        for (int s_ = 0; s_ < 16; ++s_) {
          const int s = s0 + ds * s_;
          const int sn = (s_ < 15) ? s + ds : s;
          f2v ska = {0.f, 0.f}, skb = {0.f, 0.f}, ya = {0.f, 0.f}, yb = {0.f, 0.f};
          const float vv = LV[s * RS + lane];
          const f2v vv2 = {vv, vv};
          LD_H(B, s, 1) SB(); CP_H(A, 0) SB();
          LD_K(A, s, 0) SB(); CP_H(B, 1) SB();
          const float sk = (ska.x + ska.y) + (skb.x + skb.y);
          const f2v nsk2 = {-sk, -sk};
          LD_K(B, s, 1) SB(); CP_K(A, 0) SB();
          LD_K(A, s, 2) SB(); CP_K(B, 1) SB();
          LD_K(B, s, 3) SB(); CP_K(A, 2) SB();
          LD_K(A, s, 4) SB(); CP_K(B, 3) SB();
          LD_K(B, s, 5) SB(); CP_K(A, 4) SB();
          LD_K(A, s, 6) SB(); CP_K(B, 5) SB();
          LD_K(B, s, 7) SB(); CP_K(A, 6) SB();
          LD_H(A, sn, 0) SB(); CP_K(B, 7) SB();
          LR[s * RS + lane] = (ya.x + ya.y) + (yb.x + yb.y);
        }
#undef LD_H
#undef LD_K
#undef CP_H
#undef CP_K
#undef SB
      }
      __syncthreads();
    }
    if (path == 0) {
      float* op = p.out + OUT_R + ((((size_t)(b * 2 + l) * 2 + dir) * 6 + h) * 64 + lane) * 64;
#pragma unroll
      for (int k4 = 0; k4 < 16; ++k4) {
        f4v v;
        v.xy = S[2 * k4]; v.zw = S[2 * k4 + 1];
        ((f4v*)op)[k4] = v;
      }
    }
  } else {
    bfu* Mb = p.HM + tok0 * DM + 384 + h * 64;
    {
      const float* mu0 = p.r_mu + l * 1408;
      PRM[lane] = mu0[h * 64 + lane];
      PRM[64 + lane] = mu0[384 + h * 64 + lane];
      PRM[128 + lane] = mu0[768 + h * 64 + lane];
      PRM[192 + lane] = mu0[1152 + dir * 64 + lane];
      PRM[256 + lane] = mu0[1280 + dir * 64 + lane];
      PRM[320 + lane] = p.r_rk[l * 384 + h * 64 + lane];
      PRM[384 + lane] = p.r_kk[l * 384 + h * 64 + lane];
      PRM[448 + lane] = p.r_ka[l * 384 + h * 64 + lane];
      PRM[512 + lane] = p.r_norm[l * 384 + h * 64 + lane];
      PRM[576 + lane] = p.r_w0[(l * 2 + dir) * 384 + h * 64 + lane];
      PRM[640 + lane] = p.r_a0[(l * 2 + dir) * 384 + h * 64 + lane];
    }
    if (wave < 4) {
      rwkv_prepA_tile(Ub, PRM, D, (dir ? NT - 1 : 0) * 16, T, path, h, lane);
      __syncthreads();
#pragma unroll 1
      for (int it = 0; it <= NT; ++it) {
        if (it >= 1) {
          const int k = it - 1;
          rwkv_finalize_tile(Ub, Mb, PRM, D + (k & 1) * RBUF, (dir ? NT - 1 - k : k) * 16, h, k < NT / 2, lane);
        }
        if (it + 1 < NT) {
          const int k = it + 1;
          rwkv_prepA_tile(Ub, PRM, D + (k & 1) * RBUF, (dir ? NT - 1 - k : k) * 16, T, path, h, lane);
        }
        __syncthreads();
      }
    } else {
      const bf16x8* wf = (const bf16x8*)p.WF + ((size_t)((l * 2 + dir) * 6 + h) * 16) * 64 + lane;
      rwkv_prepB_tile(Ub, PRM, D, wf, (dir ? NT - 1 : 0) * 16, T, path, dir, h, lane);
      __syncthreads();
#pragma unroll 1
      for (int it = 0; it <= NT; ++it) {
        if (it + 1 < NT) {
          const int k = it + 1;
          rwkv_prepB_tile(Ub, PRM, D + (k & 1) * RBUF, wf, (dir ? NT - 1 - k : k) * 16, T, path, dir, h, lane);
        }
        __syncthreads();
      }
    }
  }
}

#define LS 72
__device__ void mlstm_job(const Params& p, int l, int path, int unit, int wv) {
  float* smem = SMEM;
  const int tid = opaque_tid(wv);
  const int wave = tid >> 6, lane = tid & 63;
  const int dir = wave >> 2, w = wave & 3, tg = tid & 255;
  const int b = unit / 6, h = unit % 6;
  const int T = path ? 2048 : 256, NC = T >> 6;
  const size_t tok0 = path ? (size_t)NTP + (size_t)b * 2048 : (size_t)b * 256;
  const bfu* Ub = p.U + tok0 * UC;
  bfu* Mb = p.HM + tok0 * DM + h * 64;
  bfu* base = (bfu*)smem + dir * (288 * LS);
  bfu *KWT = base, *VT = base + 64 * LS, *CT = base + 144 * LS, *P = base + 224 * LS;
  float* fb = smem + (2 * 288 * LS * 2) / 4 + dir * 272;
  float *X = fb, *MX = fb + 64, *BC = fb + 128, *WK = fb + 192, *SC = fb + 256;
  const int slot = lane & 15, g4 = lane >> 4;
  f32x4 C[5];
  float mstate = 0.f;
#pragma unroll
  for (int nt = 0; nt < 5; ++nt) C[nt] = (f32x4){0.f, 0.f, 0.f, 0.f};
  if (path) {
    const size_t sb = ((size_t)(b * 2 + l) * 2 + dir) * 6 + h;
    mstate = p.sm[sb];
#pragma unroll
    for (int nt = 0; nt < 4; ++nt)
#pragma unroll
      for (int i = 0; i < 4; ++i) C[nt][i] = p.sC[(sb * 64 + 16 * w + 4 * g4 + i) * 64 + nt * 16 + slot];
    if (slot == 0)
#pragma unroll
      for (int i = 0; i < 4; ++i) C[4][i] = p.sn[sb * 64 + 16 * w + 4 * g4 + i];
  }
  for (int i = tg; i < 16 * LS; i += 256) VT[64 * LS + i] = (i < 64) ? (bfu)0x3F80 : (bfu)0;
  const float bi = p.m_bi[l * 12 + dir * 6 + h], bff = p.m_bf[l * 12 + dir * 6 + h];
  __syncthreads();
  for (int ic = 0; ic < NC; ++ic) {
    const int ch = dir ? NC - 1 - ic : ic;
    const int c0t = ch * 64;
    if (w == 0) {
      const bfu* ur = Ub + (size_t)(c0t + lane) * UC;
      const float ip = bf2f(ur[UM_I + dir * 6 + h]) + bi;
      const float fp = bf2f(ur[UM_F + dir * 6 + h]) + bff;
      const float lf = fminf(fp, 0.f) - log1pf(__expf(-fabsf(fp)));
      float bs = lf;
      if (dir == 0) {
#pragma unroll
        for (int o = 1; o < 64; o <<= 1) { float v = bperm(lane - o, bs); if (lane >= o) bs += v; }
      } else {
#pragma unroll
        for (int o = 1; o < 64; o <<= 1) { float v = bperm(lane + o, bs); if (lane + o < 64) bs += v; }
      }
      const float x = ip - bs;
      float pm = x;
      if (dir == 0) {
#pragma unroll
        for (int o = 1; o < 64; o <<= 1) { float v = bperm(lane - o, pm); if (lane >= o) pm = fmaxf(pm, v); }
      } else {
#pragma unroll
        for (int o = 1; o < 64; o <<= 1) { float v = bperm(lane + o, pm); if (lane + o < 64) pm = fmaxf(pm, v); }
      }
      const int last = dir ? 0 : 63;
      const float pmtot = bperm(last, pm), bL = bperm(last, bs);
      const float mref = fmaxf(mstate, pmtot);
      X[lane] = x; MX[lane] = fmaxf(mstate, pm); BC[lane] = bs; WK[lane] = __expf(x - mref);
      if (lane == 0) { SC[0] = __expf(mstate - mref); SC[1] = bL + mref; }
    }
#pragma unroll
    for (int nt = 0; nt < 5; ++nt) {
      uint2 o;
      o.x = pack2(C[nt][0], C[nt][1]);
      o.y = pack2(C[nt][2], C[nt][3]);
      *(uint2*)(CT + (nt * 16 + slot) * LS + 16 * w + 4 * g4) = o;
    }
    __syncthreads();
    {
      const int s = tg >> 2, cq = (tg & 3) * 16;
      const bfu* ur = Ub + (size_t)(c0t + s) * UC + h * 64 + cq;
      float kf[16];
      ld8(ur + UM_K, kf); ld8(ur + UM_K + 8, kf + 8);
      const float sc = 0.125f * WK[s];
      const uint4 v0 = *(const uint4*)(ur + UM_V), v1 = *(const uint4*)(ur + UM_V + 8);
      const unsigned vv[8] = {v0.x, v0.y, v0.z, v0.w, v1.x, v1.y, v1.z, v1.w};
#pragma unroll
      for (int j = 0; j < 16; ++j) {
        KWT[(cq + j) * LS + s] = f2bf(kf[j] * sc);
        VT[(cq + j) * LS + s] = (bfu)((j & 1) ? (vv[j >> 1] >> 16) : (vv[j >> 1] & 0xffffu));
      }
    }
    bf16x8 aq[2];
    {
      const bfu* qp = Ub + (size_t)(c0t + 16 * w + slot) * UC + UM_Q + h * 64 + 8 * g4;
      aq[0] = *(const bf16x8*)qp;
      aq[1] = *(const bf16x8*)(qp + 32);
      f32x4 aS[4];
#pragma unroll
      for (int nt = 0; nt < 4; ++nt) {
        const bfu* kp = Ub + (size_t)(c0t + nt * 16 + slot) * UC + UM_K + h * 64 + 8 * g4;
        bf16x8 k0 = *(const bf16x8*)kp, k1 = *(const bf16x8*)(kp + 32);
        aS[nt] = (f32x4){0.f, 0.f, 0.f, 0.f};
        aS[nt] = __builtin_amdgcn_mfma_f32_16x16x32_bf16(aq[0], k0, aS[nt], 0, 0, 0);
        aS[nt] = __builtin_amdgcn_mfma_f32_16x16x32_bf16(aq[1], k1, aS[nt], 0, 0, 0);
      }
#pragma unroll
      for (int i = 0; i < 4; ++i) {
        const int t = 16 * w + 4 * g4 + i;
        const float mxt = MX[t];
#pragma unroll
        for (int nt = 0; nt < 4; ++nt) {
          const int s = nt * 16 + slot;
          const bool keep = dir ? (s >= t) : (s <= t);
          const float pv = keep ? aS[nt][i] * 0.125f * __expf(X[s] - mxt) : 0.f;
          P[t * LS + s] = f2bf(pv);
        }
      }
    }
    __syncthreads();
    f32x4 hv[4];
    {
      bf16x8 ap[2];
      const bfu* pp = P + (16 * w + slot) * LS + 8 * g4;
      ap[0] = *(const bf16x8*)pp; ap[1] = *(const bf16x8*)(pp + 32);
      f32x4 aC[5], aP[5];
#pragma unroll
      for (int nt = 0; nt < 5; ++nt) {
        aC[nt] = (f32x4){0.f, 0.f, 0.f, 0.f};
        aP[nt] = (f32x4){0.f, 0.f, 0.f, 0.f};
#pragma unroll
        for (int ks = 0; ks < 2; ++ks) {
          bf16x8 bc = *(const bf16x8*)(CT + (nt * 16 + slot) * LS + 32 * ks + 8 * g4);
          bf16x8 bv = *(const bf16x8*)(VT + (nt * 16 + slot) * LS + 32 * ks + 8 * g4);
          aC[nt] = __builtin_amdgcn_mfma_f32_16x16x32_bf16(aq[ks], bc, aC[nt], 0, 0, 0);
          aP[nt] = __builtin_amdgcn_mfma_f32_16x16x32_bf16(ap[ks], bv, aP[nt], 0, 0, 0);
        }
      }
#pragma unroll
      for (int i = 0; i < 4; ++i) {
        const int t = 16 * w + 4 * g4 + i;
        const float mxt = MX[t];
        const float sc = __expf(mstate - mxt);
        float den = sc * aC[4][i] + aP[4][i];
        den = bperm(lane & 48, den);
        const float lower = __expf(-(BC[t] + mxt));
        const float inv = 1.f / fmaxf(fabsf(den), lower);
#pragma unroll
        for (int nt = 0; nt < 4; ++nt) hv[nt][i] = (sc * aC[nt][i] + aP[nt][i]) * inv;
      }
    }
#pragma unroll
    for (int i = 0; i < 4; ++i) {
      const int t = c0t + 16 * w + 4 * g4 + i;
      bfu* mp = Mb + (size_t)t * DM;
      if (ic < NC / 2) {
#pragma unroll
        for (int nt = 0; nt < 4; ++nt) mp[nt * 16 + slot] = f2bf(hv[nt][i]);
      } else {
        float hh[4];
        float ss = 0.f;
#pragma unroll
        for (int nt = 0; nt < 4; ++nt) { hh[nt] = hv[nt][i] + bf2f(mp[nt * 16 + slot]); ss += hh[nt] * hh[nt]; }
        ss += shx<1>(ss); ss += shx<2>(ss); ss += shx<4>(ss); ss += shx<8>(ss);
        const float rstd = rsqrtf(ss * (1.f / 64.f) + EPSF);
        const bfu* ur = Ub + (size_t)t * UC + h * 64;
#pragma unroll
        for (int nt = 0; nt < 4; ++nt) {
          const int e = nt * 16 + slot;
          const float o = bf2f(ur[UM_O + e]), z = bf2f(ur[UM_Z + e]);
          mp[e] = f2bf(hh[nt] * rstd * p.m_norm[l * 384 + h * 64 + e] * sigm(o) * siluf(z));
        }
      }
    }
    {
      const float dec = SC[0];
      bf16x8 ak[2];
      const bfu* kp = KWT + (16 * w + slot) * LS + 8 * g4;
      ak[0] = *(const bf16x8*)kp; ak[1] = *(const bf16x8*)(kp + 32);
#pragma unroll
      for (int nt = 0; nt < 5; ++nt) {
        f32x4 aD = {0.f, 0.f, 0.f, 0.f};
#pragma unroll
        for (int ks = 0; ks < 2; ++ks) {
          bf16x8 bv = *(const bf16x8*)(VT + (nt * 16 + slot) * LS + 32 * ks + 8 * g4);
          aD = __builtin_amdgcn_mfma_f32_16x16x32_bf16(ak[ks], bv, aD, 0, 0, 0);
        }
#pragma unroll
        for (int i = 0; i < 4; ++i) C[nt][i] = dec * C[nt][i] + aD[i];
      }
      mstate = SC[1];
    }
    __syncthreads();
  }
  if (path == 0) {
    const size_t sb = ((size_t)(b * 2 + l) * 2 + dir) * 6 + h;
#pragma unroll
    for (int nt = 0; nt < 4; ++nt)
#pragma unroll
      for (int i = 0; i < 4; ++i) p.out[OUT_C + (sb * 64 + 16 * w + 4 * g4 + i) * 64 + nt * 16 + slot] = C[nt][i];
    if (slot == 0)
#pragma unroll
      for (int i = 0; i < 4; ++i) p.out[OUT_N + sb * 64 + 16 * w + 4 * g4 + i] = C[4][i];
    if (tg == 0) p.out[OUT_M + sb] = mstate;
  }
}

__device__ void lru_job(const Params& p, int l, int path, int unit, int wv) {
  float* smem = SMEM;
  const int tid = opaque_tid(wv);
  const int wave = tid >> 6, lane = tid & 63;
  const int dir = wave >> 2, w = wave & 3, tg = tid & 255;
  const int b = unit >> 2, n = unit & 3;
  const int T = path ? 2048 : 256, NT = T >> 6;
  const size_t tok0 = path ? (size_t)NTP + (size_t)b * 2048 : (size_t)b * 256;
  const bfu* Ub = p.U + tok0 * UC;
  bfu* Mb = p.HM + tok0 * DM + 768 + n * 64;
  unsigned char* sb_ = (unsigned char*)smem + dir * 41984;
  bfu* XC = (bfu*)sb_;
  float* AA = (float*)(sb_ + 9216);
  float* BB = AA + 4096;
  const int slot = lane & 15, g4 = lane >> 4;
  const bf16x8* lf = (const bf16x8*)p.LF + ((size_t)((l * 2 + dir) * 4 + n) * 16) * 64 + lane;
  float hstate = 0.f;
  if (path) hstate = p.sL[((size_t)(b * 2 + l) * 2 + dir) * 256 + n * 64 + lane];
  for (int it = 0; it < NT; ++it) {
    const int ti = dir ? NT - 1 - it : it;
    const int t0 = ti * 64;
    const int tl = tg >> 2, cq = (tg & 3) * 16;
    {
      const int t = t0 + tl;
      float acc[16];
#pragma unroll
      for (int j = 0; j < 16; ++j) acc[j] = p.l_conv_b[l * 256 + n * 64 + cq + j];
#pragma unroll
      for (int tap = 0; tap < 4; ++tap) {
        const int ts = t + tap - 2;
        if (ts >= 0 && ts < T) {
          float xv[16];
          const bfu* ur = Ub + (size_t)ts * UC + UL + n * 64 + cq;
          ld8(ur, xv); ld8(ur + 8, xv + 8);
#pragma unroll
          for (int j = 0; j < 16; ++j) acc[j] += xv[j] * p.l_conv[(l * 4 + tap) * 256 + n * 64 + cq + j];
        }
      }
      *(uint4*)(XC + tl * LS + cq) = pack8(acc);
      *(uint4*)(XC + tl * LS + cq + 8) = pack8(acc + 8);
    }
    __syncthreads();
    {
      bf16x8 ax[2];
      const bfu* xp = XC + (16 * w + slot) * LS + 8 * g4;
      ax[0] = *(const bf16x8*)xp; ax[1] = *(const bf16x8*)(xp + 32);
#pragma unroll
      for (int nt = 0; nt < 4; ++nt) {
        f32x4 ga = {0.f, 0.f, 0.f, 0.f}, gx = {0.f, 0.f, 0.f, 0.f};
#pragma unroll
        for (int ks = 0; ks < 2; ++ks) {
          ga = __builtin_amdgcn_mfma_f32_16x16x32_bf16(ax[ks], lf[(nt * 2 + ks) * 64], ga, 0, 0, 0);
          gx = __builtin_amdgcn_mfma_f32_16x16x32_bf16(ax[ks], lf[(8 + nt * 2 + ks) * 64], gx, 0, 0, 0);
        }
        const int o = nt * 16 + slot;
        const int chn = (l * 2 + dir) * 256 + n * 64 + o;
        const float bav = p.l_ba[chn], bxv = p.l_bx[chn];
        const float lam = p.l_lambda[chn];
        const float sp = fmaxf(-lam, 0.f) + log1pf(__expf(-fabsf(lam)));
#pragma unroll
        for (int i = 0; i < 4; ++i) {
          const int t = 16 * w + 4 * g4 + i;
          const float rg = sigm(ga[i] + bav), ig = sigm(gx[i] + bxv);
          const float la = -8.f * rg * sp;
          const float a = __expf(la);
          const float bt = sqrtf(fmaxf(-expm1f(2.f * la), 0.f)) * ig * bf2f(XC[t * LS + o]);
          AA[t * 64 + o] = a;
          BB[t * 64 + o] = bt;
        }
      }
    }
    __syncthreads();
    if (w == 0) {
#pragma unroll 4
      for (int s_ = 0; s_ < 64; ++s_) {
        const int s = dir ? 63 - s_ : s_;
        hstate = AA[s * 64 + lane] * hstate + BB[s * 64 + lane];
        BB[s * 64 + lane] = hstate;
      }
    }
    __syncthreads();
    {
      const int t = t0 + tl;
      bfu* mp = Mb + (size_t)t * DM + cq;
      float y[16];
#pragma unroll
      for (int j = 0; j < 16; ++j) y[j] = BB[tl * 64 + cq + j];
      if (it >= NT / 2) {
        float pp[16], gz[16];
        ld8(mp, pp); ld8(mp + 8, pp + 8);
        const bfu* gp = Ub + (size_t)t * UC + ULZ + n * 64 + cq;
        ld8(gp, gz); ld8(gp + 8, gz + 8);
#pragma unroll
        for (int j = 0; j < 16; ++j) y[j] = (y[j] + pp[j]) * siluf(gz[j]);
      }
      *(uint4*)mp = pack8(y);
      *(uint4*)(mp + 8) = pack8(y + 8);
    }
    __syncthreads();
  }
  if (path == 0 && w == 0) p.out[OUT_L + ((size_t)(b * 2 + l) * 2 + dir) * 256 + n * 64 + lane] = hstate;
}

__device__ void phase_mix(const Params& p, int l, int wv) {
  __shared__ int sjob;
  for (;;) {
    if (wv == 0 && opaque_tid(0) == 0) sjob = (int)atomicAdd(&p.ctr[l], 1u);
    __syncthreads();
    const int job = __builtin_amdgcn_readfirstlane(sjob);
    __syncthreads();
    if (job >= 640) break;
    int type, path, idx;
    if (job < 48) { type = 0; path = 1; idx = job; }
    else if (job < 96) { type = 1; path = 1; idx = job - 48; }
    else if (job < 128) { type = 2; path = 1; idx = job - 96; }
    else if (job < 320) { type = 0; path = 0; idx = job - 128; }
    else if (job < 512) { type = 1; path = 0; idx = job - 320; }
    else { type = 2; path = 0; idx = job - 512; }
    if (type == 0) { if (PHM & 16) rwkv_job(p, l, path, idx, wv); }
    else if (type == 1) { if (PHM & 32) mlstm_job(p, l, path, idx, wv); }
    else { if (PHM & 64) lru_job(p, l, path, idx, wv); }
    __syncthreads();
    if (PROBE_SEL && wv == 0 && opaque_tid(0) == 0) {
      const int cat = job < 48 ? 0 : job < 96 ? 2 : job < 128 ? 3 : job < 320 ? 1 : job < 512 ? 4 : 5;
      atomicMax(&p.ts[16 + l * 8 + cat], (unsigned long long)wall_clock64());
    }
  }
}

template <bool USE_GRID>
__global__ void __launch_bounds__(NTHREADS) mega_kernel(Params p) {
  const int wv = __builtin_amdgcn_readfirstlane((int)(threadIdx.x >> 6));
  const int lo = (int)p.ph_lo, hi = (int)p.ph_hi;
  for (int ph = lo; ph < hi; ++ph) {
    if (ph == 0) { if (PHM & 1) phase_mod(p, wv); }
    else if (ph == 1) { if (PHM & 2) phase_h0(p, wv); }
    else {
      const int l = (ph - 2) / 3, s = (ph - 2) % 3;
      if (s == 0) { if (PHM & 4) phase_inproj(p, l, wv); }
      else if (s == 1) phase_mix(p, l, wv);
      else { if (PHM & 8) phase_outproj(p, l, wv); }
    }
    if constexpr (USE_GRID) {
      if (ph + 1 < hi || PROBE_SEL) cg::this_grid().sync();
    }
    if (PROBE_SEL && blockIdx.x == 0 && wv == 0 && opaque_tid(0) == 0) p.ts[ph + 1] = wall_clock64();

  }
  if (PROBE_SEL && blockIdx.x == 0 && wv == 0 && opaque_tid(0) == 0) {
    const unsigned long long tend = wall_clock64();
    unsigned long long d = 0;
    if (PROBE_SEL == 1) d = p.ts[2] - p.ts[1];
    else if (PROBE_SEL == 2) d = p.ts[3] - p.ts[2];
    else if (PROBE_SEL == 3) d = p.ts[4] - p.ts[3];
    else if (PROBE_SEL == 4) d = p.ts[5] - p.ts[4];
    else if (PROBE_SEL >= 5 && PROBE_SEL <= 10) d = p.ts[16 + PROBE_SEL - 5] - p.ts[3];
    else if (PROBE_SEL == 11) d = p.ts[8] - p.ts[7];
    while ((unsigned long long)wall_clock64() - tend < PROBE_MULT * d) asm volatile("s_sleep 2");
  }
}

extern "C" void kernel_launch(void* const* d_in, const int* in_sizes, int n_in, void* d_out, int out_size, void* d_ws,
                              size_t ws_size, hipStream_t stream) {
  static int grid = 0;
  if (grid == 0) {
    if (n_in != 34 || ws_size < WS_END) {
      fprintf(stderr, "kernel_launch: unexpected n_in %d or ws_size %zu (< %llu)\n", n_in, ws_size, WS_END);
      grid = -1;
      return;
    }
    int dev = 0, cus = 0, per_cu = 0;
    hipGetDevice(&dev);
    hipDeviceGetAttribute(&cus, hipDeviceAttributeMultiprocessorCount, dev);
#if COOP
    hipFuncSetAttribute((const void*)mega_kernel<true>, hipFuncAttributeMaxDynamicSharedMemorySize, LDS_BYTES);
    hipOccupancyMaxActiveBlocksPerMultiprocessor(&per_cu, (const void*)mega_kernel<true>, NTHREADS, LDS_BYTES);
#else
    hipFuncSetAttribute((const void*)mega_kernel<false>, hipFuncAttributeMaxDynamicSharedMemorySize, LDS_BYTES);
    hipOccupancyMaxActiveBlocksPerMultiprocessor(&per_cu, (const void*)mega_kernel<false>, NTHREADS, LDS_BYTES);
#endif
    if (per_cu < 1) { fprintf(stderr, "kernel_launch: occupancy query returned %d\n", per_cu); per_cu = 1; }
    if (per_cu > 1) per_cu = 1;
    grid = cus * per_cu;
  }
  if (grid < 0) return;
  Params p{};
  const float** pf = (const float**)&p;
  for (int i = 0; i < 34; ++i) pf[i] = (const float*)d_in[i];
  p.out = (float*)d_out;
  p.U = (bfu*)((char*)d_ws + WS_U);
  p.HM = (bfu*)((char*)d_ws + WS_HM);
  p.MOD = (float*)((char*)d_ws + WS_MOD);
  p.ctr = (unsigned int*)((char*)d_ws + WS_CTR);
  p.WF = (bfu*)((char*)d_ws + WS_WF);
  p.LF = (bfu*)((char*)d_ws + WS_LF);
  p.ts = (unsigned long long*)((char*)d_ws + WS_TS);
#if COOP
  p.ph_lo = 0; p.ph_hi = 8;
  void* args[] = {&p};
  hipError_t e = hipLaunchCooperativeKernel((const void*)mega_kernel<true>, dim3(grid), dim3(NTHREADS), args, LDS_BYTES, stream);
  if (e != hipSuccess) fprintf(stderr, "cooperative launch failed: %s (grid %d)\n", hipGetErrorString(e), grid);
#else
  for (int ph = 0; ph < 8; ++ph) {
    p.ph_lo = ph; p.ph_hi = ph + 1;
    hipLaunchKernelGGL(mega_kernel<false>, dim3(grid), dim3(NTHREADS), LDS_BYTES, stream, p);
  }
#endif
}
```

```cpp
#include <hip/hip_runtime.h>
#include <hip/hip_cooperative_groups.h>
#include <cstdio>
namespace cg = cooperative_groups;

#ifndef COOP
#define COOP 1
#endif

typedef __attribute__((ext_vector_type(8))) short bf16x8;
typedef __attribute__((ext_vector_type(4))) float f32x4;
typedef unsigned short bfu;

#define NTOK 24576
#define NTP 8192
#define DM 1024
#define UC 4248
#define EPSF 1e-6f
#define UM_Q 0
#define UM_K 384
#define UM_V 768
#define UM_O 1152
#define UM_Z 1536
#define UM_I 1920
#define UM_F 1932
#define UR 1944
#define URZ 3352
#define UL 3736
#define ULZ 3992

#define OUT_Y 0
#define OUT_C 25165824
#define OUT_N 28311552
#define OUT_M 28360704
#define OUT_R 28361472
#define OUT_L 31507200

#define WS_U 0ull
#define WS_HM 208797696ull
#define WS_MOD 259129344ull
#define WS_CTR 259350528ull
#define WS_WF 259350784ull
#define WS_LF 259744000ull
#define WS_END 260006144ull

#ifndef PHM
#define PHM 127
#endif
#ifndef PROBE_SEL
#define PROBE_SEL 0
#endif
#define PROBE_MULT 4
#define WS_TS 260006144ull
#define LDS_BYTES 116736
#define NTHREADS 512

extern __shared__ __attribute__((aligned(16))) unsigned char lds_raw[];
#define SMEM ((float*)lds_raw)

struct Params {
  const float *x_prompt, *x_sample, *c, *sC, *sn, *sm, *sR, *sL, *c_ctx, *g_pre, *g_post, *w_mod, *b_mod, *w_in, *w_out,
      *m_bi, *m_bf, *m_norm, *r_mu, *r_w0, *r_w2, *r_a0, *r_a2, *r_kk, *r_ka, *r_rk, *r_norm, *l_conv, *l_conv_b, *l_wa,
      *l_ba, *l_wx, *l_bx, *l_lambda;
  float* out;
  bfu* U;
  bfu* HM;
  float* MOD;
  unsigned int* ctr;
  bfu* WF;
  bfu* LF;
  unsigned long long* ts;
  long long ph_lo, ph_hi;
};

__device__ __forceinline__ int opaque_tid(int wv) {
  int ln = __builtin_amdgcn_mbcnt_hi(~0u, __builtin_amdgcn_mbcnt_lo(~0u, 0u));
  asm volatile("" : "+v"(ln));
  return wv * 64 + ln;
}
template <int M>
__device__ __forceinline__ float shx(float v) {
  return __builtin_bit_cast(float, __builtin_amdgcn_ds_swizzle(__builtin_bit_cast(int, v), (M << 10) | 0x1F));
}
__device__ __forceinline__ float bperm(int srclane, float v) {
  return __builtin_bit_cast(float, __builtin_amdgcn_ds_bpermute(srclane << 2, __builtin_bit_cast(int, v)));
}
__device__ __forceinline__ bfu f2bf(float f) {
  unsigned u = __float_as_uint(f);
  u += 0x7fffu + ((u >> 16) & 1u);
  return (bfu)(u >> 16);
}
__device__ __forceinline__ float bf2f(bfu h) { return __uint_as_float(((unsigned)h) << 16); }
__device__ __forceinline__ unsigned pack2(float a, float b) { return (unsigned)f2bf(a) | ((unsigned)f2bf(b) << 16); }
__device__ __forceinline__ float sigm(float x) { return __builtin_amdgcn_rcpf(1.f + __expf(-x)); }
__device__ __forceinline__ float siluf(float x) { return x * __builtin_amdgcn_rcpf(1.f + __expf(-x)); }
__device__ __forceinline__ void unpack8(uint4 v, float* f) {
  f[0] = __uint_as_float(v.x << 16); f[1] = __uint_as_float(v.x & 0xffff0000u);
  f[2] = __uint_as_float(v.y << 16); f[3] = __uint_as_float(v.y & 0xffff0000u);
  f[4] = __uint_as_float(v.z << 16); f[5] = __uint_as_float(v.z & 0xffff0000u);
  f[6] = __uint_as_float(v.w << 16); f[7] = __uint_as_float(v.w & 0xffff0000u);
}
__device__ __forceinline__ void ld8(const bfu* p, float* f) { unpack8(*(const uint4*)p, f); }
__device__ __forceinline__ void ld8acc(const bfu* p, float* f) {
  float t[8]; unpack8(*(const uint4*)p, t);
#pragma unroll
  for (int j = 0; j < 8; ++j) f[j] += t[j];
}
__device__ __forceinline__ uint4 pack8(const float* f) {
  uint4 v; v.x = pack2(f[0], f[1]); v.y = pack2(f[2], f[3]); v.z = pack2(f[4], f[5]); v.w = pack2(f[6], f[7]);
  return v;
}
struct ShW { int tm1, tp1, tmd, tpd; float wm1, wp1, wmd, wpd; };
struct Sh5 { uint4 r0, r1, r2, r3, r4; };
__device__ __forceinline__ ShW shift_weights(int t, int T, int path) {
  ShW w;
  const int d = path ? 64 : 1;
  const float cf = path ? 0.25f : 0.5f;
  w.tm1 = max(t - 1, 0); w.tp1 = min(t + 1, T - 1); w.tmd = max(t - d, 0); w.tpd = min(t + d, T - 1);
  w.wm1 = (path ? (t & 63) > 0 : t > 0) ? cf : 0.f;
  w.wp1 = (path ? (t & 63) < 63 : t < T - 1) ? cf : 0.f;
  w.wmd = (path && t >= 64) ? cf : 0.f;
  w.wpd = (path && t < T - 64) ? cf : 0.f;
  return w;
}
__device__ __forceinline__ void shift_issue(const bfu* Ub, int t, const ShW& w, Sh5& o) {
  o.r0 = *(const uint4*)(Ub + (size_t)t * UC);
  o.r1 = *(const uint4*)(Ub + (size_t)w.tm1 * UC);
  o.r2 = *(const uint4*)(Ub + (size_t)w.tp1 * UC);
  o.r3 = *(const uint4*)(Ub + (size_t)w.tmd * UC);
  o.r4 = *(const uint4*)(Ub + (size_t)w.tpd * UC);
}
__device__ __forceinline__ void shift_finish(const Sh5& o, const ShW& w, const float* mu, float* blk) {
  float u[8], a[8];
  unpack8(o.r0, u);
  unpack8(o.r1, a);
  float sh[8];
#pragma unroll
  for (int j = 0; j < 8; ++j) sh[j] = w.wm1 * a[j];
  unpack8(o.r2, a);
#pragma unroll
  for (int j = 0; j < 8; ++j) sh[j] += w.wp1 * a[j];
  unpack8(o.r3, a);
#pragma unroll
  for (int j = 0; j < 8; ++j) sh[j] += w.wmd * a[j];
  unpack8(o.r4, a);
#pragma unroll
  for (int j = 0; j < 8; ++j) sh[j] += w.wpd * a[j];
#pragma unroll
  for (int j = 0; j < 8; ++j) blk[j] = u[j] + mu[j] * (sh[j] - u[j]);
}

__device__ void phase_mod(const Params& p, int wv) {
  float* smem = SMEM;
  const int tid = opaque_tid(wv);
  if (blockIdx.x == 0 && tid < 8) p.ctr[tid] = 0u;
  if (PROBE_SEL && blockIdx.x == 0 && tid < 64) p.ts[tid] = 0ull;
  for (int idx = blockIdx.x * NTHREADS + tid; idx < 24576 + 16384; idx += gridDim.x * NTHREADS) {
    float f[8];
    if (idx < 24576) {
      const int ln = idx & 63, fr = (idx >> 6) & 7, mat = (idx >> 9) & 1, hd = idx >> 10;
      const int h = hd % 6, ld = hd / 6, nt = fr >> 1, ks = fr & 1;
      const float* src = mat ? p.r_a2 : p.r_w2;
#pragma unroll
      for (int j = 0; j < 8; ++j) f[j] = src[((size_t)ld * 64 + 8 * (ln >> 4) + j + 32 * ks) * 384 + h * 64 + nt * 16 + (ln & 15)];
      *(uint4*)(p.WF + (size_t)idx * 8) = pack8(f);
    } else {
      const int id2 = idx - 24576;
      const int ln = id2 & 63, fr = (id2 >> 6) & 7, mat = (id2 >> 9) & 1, ldn = id2 >> 10;
      const int nt = fr >> 1, ks = fr & 1;
      const float* src = mat ? p.l_wx : p.l_wa;
#pragma unroll
      for (int j = 0; j < 8; ++j) f[j] = src[((size_t)ldn * 64 + 8 * (ln >> 4) + j + 32 * ks) * 64 + nt * 16 + (ln & 15)];
      *(uint4*)(p.LF + (size_t)id2 * 8) = pack8(f);
    }
  }
  for (int i = tid; i < 9 * 1024; i += NTHREADS) {
    int v = i >> 10, k = i & 1023;
    float cv = (v == 0) ? p.c_ctx[k] : p.c[(v - 1) * 1024 + k];
    smem[i] = siluf(cv);
  }
  __syncthreads();
  float* red = smem + 9 * 1024;
  const int col = tid & 31, kg = tid >> 5;
  for (int chunk = blockIdx.x; chunk < 192; chunk += gridDim.x) {
    const int l = chunk / 96, n0 = (chunk % 96) * 32;
    const float* w = p.w_mod + (size_t)l * 1024 * 3072 + n0 + col;
    float acc[9];
#pragma unroll
    for (int v = 0; v < 9; ++v) acc[v] = 0.f;
    for (int k = kg * 64; k < kg * 64 + 64; ++k) {
      float wv = w[(size_t)k * 3072];
#pragma unroll
      for (int v = 0; v < 9; ++v) acc[v] += smem[v * 1024 + k] * wv;
    }
#pragma unroll
    for (int v = 0; v < 9; ++v) red[(kg * 9 + v) * 32 + col] = acc[v];
    __syncthreads();
    if (tid < 288) {
      int v = tid >> 5;
      float s = 0.f;
      for (int g = 0; g < 16; ++g) s += red[(g * 9 + v) * 32 + col];
      p.MOD[(size_t)(l * 9 + v) * 3072 + n0 + col] = s + p.b_mod[l * 3072 + n0 + col];
    }
    __syncthreads();
  }
}

__device__ __forceinline__ int modvec(int row) { return row < NTP ? 0 : 1 + ((row - NTP) >> 11); }

__device__ void phase_h0(const Params& p, int wv) {
  const int tid = opaque_tid(wv);
  const int wave = tid >> 6, lane = tid & 63;
  for (int row = blockIdx.x * 8 + wave; row < NTOK; row += gridDim.x * 8) {
    const float* xr = row < NTP ? p.x_prompt + (size_t)row * DM : p.x_sample + (size_t)(row - NTP) * DM;
    float4 v[4];
    float ss = 0.f;
#pragma unroll
    for (int j = 0; j < 4; ++j) {
      v[j] = ((const float4*)xr)[lane + 64 * j];
      ss += v[j].x * v[j].x + v[j].y * v[j].y + v[j].z * v[j].z + v[j].w * v[j].w;
    }
    ss += shx<1>(ss); ss += shx<2>(ss); ss += shx<4>(ss); ss += shx<8>(ss); ss += shx<16>(ss);
    ss = __builtin_amdgcn_readlane(ss, 0) + __builtin_amdgcn_readlane(ss, 32);
    const float rstd = rsqrtf(ss * (1.f / 1024.f) + EPSF);
    const float* md = p.MOD + (size_t)modvec(row) * 3072;
#pragma unroll
    for (int j = 0; j < 4; ++j) {
      const int k = (lane + 64 * j) * 4;
      float4 g = *(const float4*)(p.g_pre + k);
      float4 sh = *(const float4*)(md + k);
      float4 sc = *(const float4*)(md + 1024 + k);
      uint2 o;
      o.x = pack2(v[j].x * rstd * g.x * (1.f + sc.x) + sh.x, v[j].y * rstd * g.y * (1.f + sc.y) + sh.y);
      o.y = pack2(v[j].z * rstd * g.z * (1.f + sc.z) + sh.z, v[j].w * rstd * g.w * (1.f + sc.w) + sh.w);
      *(uint2*)(p.HM + (size_t)row * DM + k) = o;
    }
  }
}

#define LDK 40
__device__ __forceinline__ int ldsrow(int n) { return (n & ~63) | ((n & 3) << 4) | ((n >> 2) & 15); }

template <int BM, int BN, int WM, int WN, bool PREF>
__device__ __forceinline__ void gemm_mainloop(const bfu* __restrict__ A, const float* __restrict__ B, int ldb, int n0,
                                              int nvalid, bfu* As, bfu* Bs, f32x4 (&acc)[BM / WM / 16][BN / WN / 16], const int tid) {
  constexpr int TM = BM / WM / 16, TN = BN / WN / 16;
  constexpr int NA = (BM * 4 + NTHREADS - 1) / NTHREADS;
  constexpr int NB = BN * 4 / NTHREADS;
  constexpr int NBH = PREF ? NB : 2;
  const int wave = tid >> 6, lane = tid & 63;
  const int wm = wave / WN, wn = wave % WN;
  const int mbase = wm * (BM / WM), nbase = wn * (BN / WN);
#pragma unroll
  for (int i = 0; i < TM; ++i)
#pragma unroll
    for (int j = 0; j < TN; ++j) acc[i][j] = (f32x4){0.f, 0.f, 0.f, 0.f};

  const __amdgpu_buffer_rsrc_t rsrc = __builtin_amdgcn_make_buffer_rsrc((void*)B, 0, 1024 * ldb * 4, 0x00020000);
  uint4 ra[NA];
  float rb[NBH][8];
#pragma unroll
  for (int j = 0; j < NA; ++j) ra[j] = make_uint4(0u, 0u, 0u, 0u);

#define G_LOADA(ks_)                                                                                        \
  _Pragma("unroll") for (int j = 0; j < NA; ++j) {                                                          \
    const int c = tid + NTHREADS * j;                                                                       \
    if (c < BM * 4) ra[j] = *(const uint4*)(A + (size_t)(c >> 2) * DM + (ks_) * 32 + (c & 3) * 8);          \
  }
#define G_STOREA()                                                                                          \
  _Pragma("unroll") for (int j = 0; j < NA; ++j) {                                                          \
    const int c = tid + NTHREADS * j;                                                                       \
    if (c < BM * 4) *(uint4*)(As + (c >> 2) * LDK + (c & 3) * 8) = ra[j];                                   \
  }
#define G_LOADB(ks_, j0_)                                                                                   \
  _Pragma("unroll") for (int j = 0; j < NBH; ++j) {                                                         \
    const int u = tid + NTHREADS * (j + (j0_));                                                             \
    const int n = u % BN, kg = u / BN;                                                                      \
    const unsigned voff = (n < nvalid) ? (unsigned)((kg * 8 * ldb + n0 + n) * 4) : 0x80000000u;             \
    _Pragma("unroll") for (int jj = 0; jj < 8; ++jj) rb[j][jj] = __builtin_bit_cast(                        \
        float, __builtin_amdgcn_raw_buffer_load_b32(rsrc, voff, (unsigned)(((ks_) * 32 + jj) * ldb * 4), 0)); \
  }
#define G_STOREB(j0_)                                                                                       \
  _Pragma("unroll") for (int j = 0; j < NBH; ++j) {                                                         \
    const int u = tid + NTHREADS * (j + (j0_));                                                             \
    const int n = u % BN, kg = u / BN;                                                                      \
    uint4 pk;                                                                                               \
    pk.x = pack2(rb[j][0], rb[j][1]); pk.y = pack2(rb[j][2], rb[j][3]);                                     \
    pk.z = pack2(rb[j][4], rb[j][5]); pk.w = pack2(rb[j][6], rb[j][7]);                                     \
    *(uint4*)(Bs + ldsrow(n) * LDK + kg * 8) = pk;                                                          \
  }

  if (PREF) {
    G_LOADA(0)
    G_LOADB(0, 0)
  }
#pragma unroll 1
  for (int ks = 0; ks < 32; ++ks) {
    if (PREF) {
      G_STOREA()
      G_STOREB(0)
    } else {
      G_LOADA(ks)
      G_STOREA()
#pragma unroll 1
      for (int j0 = 0; j0 < NB; j0 += NBH) {
        G_LOADB(ks, j0)
        G_STOREB(j0)
      }
    }
    __syncthreads();
    if (PREF && ks + 1 < 32) {
      G_LOADA(ks + 1)
      G_LOADB(ks + 1, 0)
    }
    bf16x8 af[TM];
#pragma unroll
    for (int i = 0; i < TM; ++i) af[i] = *(const bf16x8*)(As + (mbase + i * 16 + (lane & 15)) * LDK + (lane >> 4) * 8);
#pragma unroll
    for (int j = 0; j < TN; ++j) {
      const bf16x8 bfr = *(const bf16x8*)(Bs + (nbase + j * 16 + (lane & 15)) * LDK + (lane >> 4) * 8);
#pragma unroll
      for (int i = 0; i < TM; ++i) acc[i][j] = __builtin_amdgcn_mfma_f32_16x16x32_bf16(af[i], bfr, acc[i][j], 0, 0, 0);
    }
    __syncthreads();
  }
#undef G_LOADA
#undef G_STOREA
#undef G_LOADB
#undef G_STOREB
}

__device__ void phase_inproj(const Params& p, int l, int wv) {
  float* smem = SMEM;
  bfu* As = (bfu*)smem;
  bfu* Bs = As + 256 * LDK;
  const int tid = opaque_tid(wv);
  const int wave = tid >> 6, lane = tid & 63;
  const int wm = wave >> 2, wn = wave & 3;
  for (int tile = blockIdx.x; tile < 96 * 17; tile += gridDim.x) {
    const int m0 = (tile / 17) * 256, n0 = (tile % 17) * 256;
    const int nvalid = min(256, UC - n0);
    f32x4 acc[8][4];
    gemm_mainloop<256, 256, 2, 4, true>(p.HM + (size_t)m0 * DM, p.w_in + (size_t)l * DM * UC, UC, n0, nvalid, As, Bs, acc, tid);
    const int slot = lane & 15, g4 = lane >> 4;
    const int c = n0 + wn * 64 + 4 * slot;
    if (c < UC) {
#pragma unroll
      for (int mt = 0; mt < 8; ++mt)
#pragma unroll
        for (int i = 0; i < 4; ++i) {
          const int row = m0 + wm * 128 + mt * 16 + 4 * g4 + i;
          uint2 o;
          o.x = pack2(acc[mt][0][i], acc[mt][1][i]);
          o.y = pack2(acc[mt][2][i], acc[mt][3][i]);
          *(uint2*)(p.U + (size_t)row * UC + c) = o;
        }
    }
  }
}

__device__ void phase_outproj(const Params& p, int l, int wv) {
  float* smem = SMEM;
  bfu* As = (bfu*)smem;
  bfu* Bs = As + 32 * LDK;
  float* red = (float*)(Bs + 1024 * LDK);
  float* rs = red + 256;
  const int tid = opaque_tid(wv);
  const int wave = tid >> 6, lane = tid & 63;
  const int slot = lane & 15, g4 = lane >> 4;
  for (int tile = blockIdx.x; tile < NTOK / 32; tile += gridDim.x) {
    const int m0 = tile * 32;
    f32x4 acc[2][8];
    gemm_mainloop<32, 1024, 1, 8, true>(p.HM + (size_t)m0 * DM, p.w_out + (size_t)l * DM * DM, DM, 0, DM, As, Bs, acc, tid);
#pragma unroll
    for (int mt = 0; mt < 2; ++mt)
#pragma unroll
      for (int i = 0; i < 4; ++i) {
        float s = 0.f;
#pragma unroll
        for (int nt = 0; nt < 8; ++nt) s += acc[mt][nt][i] * acc[mt][nt][i];
        s += shx<1>(s); s += shx<2>(s); s += shx<4>(s); s += shx<8>(s);
        if (slot == 0) red[wave * 32 + mt * 16 + 4 * g4 + i] = s;
      }
    __syncthreads();
    if (tid < 32) {
      float s = 0.f;
      for (int w = 0; w < 8; ++w) s += red[w * 32 + tid];
      rs[tid] = rsqrtf(s * (1.f / 1024.f) + EPSF);
    }
    __syncthreads();
    const int vec = modvec(m0);
    const float* md = p.MOD + (size_t)(l * 9 + vec) * 3072;
#pragma unroll
    for (int mt = 0; mt < 2; ++mt)
#pragma unroll
      for (int i = 0; i < 4; ++i) {
        const int rl = mt * 16 + 4 * g4 + i;
        const int row = m0 + rl;
        const float rstd = rs[rl];
        const float* xin = (l == 0) ? (row < NTP ? p.x_prompt + (size_t)row * DM : p.x_sample + (size_t)(row - NTP) * DM)
                                    : p.out + OUT_Y + (size_t)row * DM;
#pragma unroll
        for (int q = 0; q < 2; ++q) {
          const int c = wave * 128 + 64 * q + 4 * slot;
          float4 xi = *(const float4*)(xin + c);
          float4 gt = *(const float4*)(md + 2048 + c);
          float4 gp = *(const float4*)(p.g_post + l * DM + c);
          float4 xn;
          xn.x = xi.x + gt.x * (acc[mt][4 * q + 0][i] * rstd * gp.x);
          xn.y = xi.y + gt.y * (acc[mt][4 * q + 1][i] * rstd * gp.y);
          xn.z = xi.z + gt.z * (acc[mt][4 * q + 2][i] * rstd * gp.z);
          xn.w = xi.w + gt.w * (acc[mt][4 * q + 3][i] * rstd * gp.w);
          *(float4*)(p.out + OUT_Y + (size_t)row * DM + c) = xn;
          acc[mt][4 * q + 0][i] = xn.x; acc[mt][4 * q + 1][i] = xn.y; acc[mt][4 * q + 2][i] = xn.z; acc[mt][4 * q + 3][i] = xn.w;
        }
        __builtin_amdgcn_sched_barrier(0);
      }
    if (l == 0) {
      __syncthreads();
#pragma unroll
      for (int mt = 0; mt < 2; ++mt)
#pragma unroll
        for (int i = 0; i < 4; ++i) {
          float s = 0.f;
#pragma unroll
          for (int nt = 0; nt < 8; ++nt) s += acc[mt][nt][i] * acc[mt][nt][i];
          s += shx<1>(s); s += shx<2>(s); s += shx<4>(s); s += shx<8>(s);
          if (slot == 0) red[wave * 32 + mt * 16 + 4 * g4 + i] = s;
        }
      __syncthreads();
      if (tid < 32) {
        float s = 0.f;
        for (int w = 0; w < 8; ++w) s += red[w * 32 + tid];
        rs[tid] = rsqrtf(s * (1.f / 1024.f) + EPSF);
      }
      __syncthreads();
      const float* md1 = p.MOD + (size_t)(9 + vec) * 3072;
#pragma unroll
      for (int mt = 0; mt < 2; ++mt)
#pragma unroll
        for (int i = 0; i < 4; ++i) {
          const int rl = mt * 16 + 4 * g4 + i;
          const int row = m0 + rl;
          const float rstd = rs[rl];
#pragma unroll
          for (int q = 0; q < 2; ++q) {
            const int c = wave * 128 + 64 * q + 4 * slot;
            float4 g = *(const float4*)(p.g_pre + DM + c);
            float4 sh = *(const float4*)(md1 + c);
            float4 sc = *(const float4*)(md1 + 1024 + c);
            uint2 o;
            o.x = pack2(acc[mt][4 * q + 0][i] * rstd * g.x * (1.f + sc.x) + sh.x, acc[mt][4 * q + 1][i] * rstd * g.y * (1.f + sc.y) + sh.y);
            o.y = pack2(acc[mt][4 * q + 2][i] * rstd * g.z * (1.f + sc.z) + sh.z, acc[mt][4 * q + 3][i] * rstd * g.w * (1.f + sc.w) + sh.w);
            *(uint2*)(p.HM + (size_t)row * DM + c) = o;
          }
          __builtin_amdgcn_sched_barrier(0);
        }
    }
    __syncthreads();
  }
}

#define RS 68
#define RBUF (6 * 16 * RS + 16)
typedef float f2v __attribute__((ext_vector_type(2)));
typedef float f4v __attribute__((ext_vector_type(4)));

__device__ __forceinline__ void rwkv_prepA_iter(const bfu* Ub, bfu* Mb, const float* PRM, const float* fbuf, float* pbuf, bool do_fin,
                                                bool first_half, int ft0, bool do_prep, int pt0, int T, int path, int h, int lane) {
  const int tl = lane >> 2, c0 = (lane & 3) * 16;
  f4v y4[4], v4[4];
  uint4 pp0, pp1, gz0, gz1;
  float bonf = 0.f;
  bfu* mp = Mb + (size_t)(ft0 + tl) * DM + c0;
  pp0 = pp1 = gz0 = gz1 = make_uint4(0u, 0u, 0u, 0u);
#pragma unroll
  for (int j4 = 0; j4 < 4; ++j4) { y4[j4] = (f4v){0.f, 0.f, 0.f, 0.f}; v4[j4] = (f4v){0.f, 0.f, 0.f, 0.f}; }
  if (do_fin) {
    const float *LR = fbuf, *LV = fbuf + 16 * RS, *BON = fbuf + 96 * RS;
#pragma unroll
    for (int j4 = 0; j4 < 4; ++j4) {
      y4[j4] = *(const f4v*)(LR + tl * RS + c0 + 4 * j4);
      v4[j4] = *(const f4v*)(LV + tl * RS + c0 + 4 * j4);
    }
    bonf = BON[tl];
    if (!first_half) {
      pp0 = *(const uint4*)mp; pp1 = *(const uint4*)(mp + 8);
      const bfu* gp = Ub + (size_t)(ft0 + tl) * UC + URZ + h * 64 + c0;
      gz0 = *(const uint4*)gp; gz1 = *(const uint4*)(gp + 8);
    }
  }
  __builtin_amdgcn_sched_barrier(0);
  if (do_prep) {
    float *LR = pbuf, *LV = pbuf + 16 * RS, *BON = pbuf + 96 * RS;
    const int t = pt0 + tl;
    const ShW sw = shift_weights(t, T, path);
    float part = 0.f;
#pragma unroll
    for (int hh = 0; hh < 2; ++hh) {
      const int cl = c0 + hh * 8;
      Sh5 lr, lk, lv;
      shift_issue(Ub + UR + h * 64 + cl, t, sw, lr);
      shift_issue(Ub + UR + 384 + h * 64 + cl, t, sw, lk);
      shift_issue(Ub + UR + 768 + h * 64 + cl, t, sw, lv);
      __builtin_amdgcn_sched_barrier(0);
      float rr[8], kk[8];
      shift_finish(lr, sw, PRM + cl, rr);
      *(f4v*)(LR + tl * RS + cl) = (f4v){rr[0], rr[1], rr[2], rr[3]};
      *(f4v*)(LR + tl * RS + cl + 4) = (f4v){rr[4], rr[5], rr[6], rr[7]};
      __builtin_amdgcn_sched_barrier(0);
      shift_finish(lk, sw, PRM + 64 + cl, kk);
#pragma unroll
      for (int j = 0; j < 8; ++j) part += rr[j] * kk[j] * PRM[320 + cl + j];
      __builtin_amdgcn_sched_barrier(0);
      shift_finish(lv, sw, PRM + 128 + cl, rr);
      *(f4v*)(LV + tl * RS + cl) = (f4v){rr[0], rr[1], rr[2], rr[3]};
      *(f4v*)(LV + tl * RS + cl + 4) = (f4v){rr[4], rr[5], rr[6], rr[7]};
      __builtin_amdgcn_sched_barrier(0);
    }
    part += shx<1>(part);
    part += shx<2>(part);
    BON[tl] = part;
  }
  __builtin_amdgcn_sched_barrier(0);
  if (do_fin) {
    float y[16];
#pragma unroll
    for (int j4 = 0; j4 < 4; ++j4) { y[4 * j4] = y4[j4][0]; y[4 * j4 + 1] = y4[j4][1]; y[4 * j4 + 2] = y4[j4][2]; y[4 * j4 + 3] = y4[j4][3]; }
    if (!first_half) {
      float pp[16], gz[16];
      unpack8(pp0, pp); unpack8(pp1, pp + 8);
      unpack8(gz0, gz); unpack8(gz1, gz + 8);
      float ss = 0.f;
#pragma unroll
      for (int j = 0; j < 16; ++j) { y[j] += pp[j]; ss += y[j] * y[j]; }
      ss += shx<1>(ss);
      ss += shx<2>(ss);
      const float rstd = rsqrtf(ss * (1.f / 64.f) + EPSF);
#pragma unroll
      for (int j = 0; j < 16; ++j) {
        float o = y[j] * rstd * PRM[512 + c0 + j] + bonf * v4[j >> 2][j & 3];
        y[j] = o * siluf(gz[j]);
      }
    }
    *(uint4*)mp = pack8(y);
    *(uint4*)(mp + 8) = pack8(y + 8);
  }
}
__device__ __forceinline__ void rwkv_prepB_tile(const bfu* Ub, const float* PRM, float* buf, const bf16x8* wf, int t0, int T, int path,
                                                int dir, int h, int lane) {
  float *LKH = buf + 32 * RS, *LW = buf + 48 * RS, *LB = buf + 64 * RS, *LKT = buf + 80 * RS;
  const int tl = lane >> 2, c0 = (lane & 3) * 16;
  const int slot = lane & 15, g4 = lane >> 4;
  {
    const int t = t0 + slot;
    bf16x8 awl[2], aal[2];
    const ShW sw = shift_weights(t, T, path);
    Sh5 lw0, lw1, la0, la1;
    shift_issue(Ub + UR + 1152 + dir * 64 + 8 * g4, t, sw, lw0);
    shift_issue(Ub + UR + 1152 + dir * 64 + 32 + 8 * g4, t, sw, lw1);
    shift_issue(Ub + UR + 1280 + dir * 64 + 8 * g4, t, sw, la0);
    shift_issue(Ub + UR + 1280 + dir * 64 + 32 + 8 * g4, t, sw, la1);
    __builtin_amdgcn_sched_barrier(0);
    {
      float blk[8];
      shift_finish(lw0, sw, PRM + 192 + 8 * g4, blk);
#pragma unroll
      for (int j = 0; j < 8; ++j) awl[0][j] = (short)f2bf(1.f - 2.f * __builtin_amdgcn_rcpf(1.f + __expf(2.f * blk[j])));
      __builtin_amdgcn_sched_barrier(0);
      shift_finish(lw1, sw, PRM + 192 + 32 + 8 * g4, blk);
#pragma unroll
      for (int j = 0; j < 8; ++j) awl[1][j] = (short)f2bf(1.f - 2.f * __builtin_amdgcn_rcpf(1.f + __expf(2.f * blk[j])));
      __builtin_amdgcn_sched_barrier(0);
      shift_finish(la0, sw, PRM + 256 + 8 * g4, blk);
#pragma unroll
      for (int j = 0; j < 8; ++j) aal[0][j] = (short)f2bf(blk[j]);
      __builtin_amdgcn_sched_barrier(0);
      shift_finish(la1, sw, PRM + 256 + 32 + 8 * g4, blk);
#pragma unroll
      for (int j = 0; j < 8; ++j) aal[1][j] = (short)f2bf(blk[j]);
      __builtin_amdgcn_sched_barrier(0);
    }
#pragma unroll
    for (int nt = 0; nt < 4; ++nt) {
      f32x4 aw = {0.f, 0.f, 0.f, 0.f}, aa = {0.f, 0.f, 0.f, 0.f};
#pragma unroll
      for (int ks = 0; ks < 2; ++ks) {
        aw = __builtin_amdgcn_mfma_f32_16x16x32_bf16(awl[ks], wf[(nt * 2 + ks) * 64], aw, 0, 0, 0);
        aa = __builtin_amdgcn_mfma_f32_16x16x32_bf16(aal[ks], wf[(8 + nt * 2 + ks) * 64], aa, 0, 0, 0);
      }
      const int col = nt * 16 + slot;
      const float w0v = PRM[576 + col];
      const float a0v = PRM[640 + col];
#pragma unroll
      for (int i = 0; i < 4; ++i) {
        const int tt = 4 * g4 + i;
        LW[tt * RS + col] = __expf(-0.6065306597126334f * sigm(w0v + aw[i]));
        LB[tt * RS + col] = sigm(a0v + aa[i]);
      }
    }
  }
  {
    const int t = t0 + tl;
    float kr[16], kap[16];
    const ShW sw = shift_weights(t, T, path);
    Sh5 lk0, lk1;
    shift_issue(Ub + UR + 384 + h * 64 + c0, t, sw, lk0);
    shift_issue(Ub + UR + 384 + h * 64 + c0 + 8, t, sw, lk1);
    shift_finish(lk0, sw, PRM + 64 + c0, kr);
    shift_finish(lk1, sw, PRM + 64 + c0 + 8, kr + 8);
    float ss = 0.f;
#pragma unroll
    for (int j = 0; j < 16; ++j) { kap[j] = kr[j] * PRM[384 + c0 + j]; ss += kap[j] * kap[j]; }
    ss += shx<1>(ss);
    ss += shx<2>(ss);
    const float inv = 1.f / fmaxf(sqrtf(ss), 1e-12f);
#pragma unroll
    for (int j4 = 0; j4 < 4; ++j4) {
      const f4v a4 = *(const f4v*)(LB + tl * RS + c0 + 4 * j4);
      f4v kh4, kt4, b4;
#pragma unroll
      for (int e = 0; e < 4; ++e) {
        const int j = 4 * j4 + e;
        const float kh = kap[j] * inv;
        kh4[e] = kh;
        kt4[e] = kr[j] * (1.f + (a4[e] - 1.f) * PRM[448 + c0 + j]);
        b4[e] = kh * a4[e];
      }
      *(f4v*)(LKH + tl * RS + c0 + 4 * j4) = kh4;
      *(f4v*)(LKT + tl * RS + c0 + 4 * j4) = kt4;
      *(f4v*)(LB + tl * RS + c0 + 4 * j4) = b4;
    }
  }
}

__device__ void rwkv_job(const Params& p, int l, int path, int unit, int wv) {
  float* smem = SMEM;
  const int tid = opaque_tid(wv);
  const int wave = wv, lane = tid & 63;
  const int b = unit / 6, h = unit % 6;
  const int T = path ? 2048 : 256, NT = T >> 4;
  if (wave == 4 || wave == 5) {
#pragma unroll 1
    for (int i = 0; i < NT + 2; ++i) __syncthreads();
    return;
  }
  const int dir = wave & 1;
  const size_t tok0 = path ? (size_t)NTP + (size_t)b * 2048 : (size_t)b * 256;
  const bfu* Ub = p.U + tok0 * UC;
  float* D = smem + dir * (2 * RBUF + 1408);
  float* PRM = D + 2 * RBUF + (wave >= 6 ? 704 : 0);
  if (wave < 2) {
    f2v S[32];
    if (path) {
      const float* sp = p.sR + ((((size_t)(b * 2 + l) * 2 + dir) * 6 + h) * 64 + lane) * 64;
#pragma unroll
      for (int k4 = 0; k4 < 16; ++k4) {
        f4v v = ((const f4v*)sp)[k4];
        S[2 * k4] = v.xy; S[2 * k4 + 1] = v.zw;
      }
    } else {
#pragma unroll
      for (int k = 0; k < 32; ++k) S[k] = (f2v){0.f, 0.f};
    }
    __syncthreads();
#pragma unroll 1
    for (int it = 0; it <= NT; ++it) {
      if (it < NT) {
        float* buf = D + (it & 1) * RBUF;
        float *LR = buf, *LV = buf + 16 * RS;
        f4v A[8], B[8];
#define LD_H(dst, s_, hf_)                                                               \
  {                                                                                      \
    const f4v* q = (const f4v*)(buf + 32 * RS + (s_) * RS) + 8 * (hf_);                  \
    _Pragma("unroll") for (int i = 0; i < 8; ++i) dst[i] = q[i];                         \
  }
#define LD_K(dst, s_, g_)                                                                \
  {                                                                                      \
    const f4v* qw = (const f4v*)(buf + 48 * RS + (s_) * RS) + 2 * (g_);                  \
    const f4v* qb = (const f4v*)(buf + 64 * RS + (s_) * RS) + 2 * (g_);                  \
    const f4v* qk = (const f4v*)(buf + 80 * RS + (s_) * RS) + 2 * (g_);                  \
    const f4v* qr = (const f4v*)(buf + (s_) * RS) + 2 * (g_);                            \
    _Pragma("unroll") for (int i = 0; i < 2; ++i) {                                      \
      dst[4 * i] = qw[i]; dst[4 * i + 1] = qb[i]; dst[4 * i + 2] = qk[i]; dst[4 * i + 3] = qr[i]; \
    }                                                                                    \
  }
#define CP_H(src, hf_)                                                                   \
  {                                                                                      \
    _Pragma("unroll") for (int i = 0; i < 8; ++i) {                                      \
      ska = __builtin_elementwise_fma(S[2 * (8 * (hf_) + i)], src[i].xy, ska);           \
      skb = __builtin_elementwise_fma(S[2 * (8 * (hf_) + i) + 1], src[i].zw, skb);       \
    }                                                                                    \
  }
#define CP_K(src, g_)                                                                    \
  {                                                                                      \
    _Pragma("unroll") for (int i = 0; i < 2; ++i) {                                      \
      const int k4 = 2 * (g_) + i;                                                       \
      f2v t0 = vv2 * src[4 * i + 2].xy, t1 = vv2 * src[4 * i + 2].zw;                    \
      t0 = __builtin_elementwise_fma(nsk2, src[4 * i + 1].xy, t0);                       \
      t1 = __builtin_elementwise_fma(nsk2, src[4 * i + 1].zw, t1);                       \
      S[2 * k4] = __builtin_elementwise_fma(S[2 * k4], src[4 * i].xy, t0);               \
      S[2 * k4 + 1] = __builtin_elementwise_fma(S[2 * k4 + 1], src[4 * i].zw, t1);       \
      ya = __builtin_elementwise_fma(S[2 * k4], src[4 * i + 3].xy, ya);                  \
      yb = __builtin_elementwise_fma(S[2 * k4 + 1], src[4 * i + 3].zw, yb);              \
    }                                                                                    \
  }
#define SB() __builtin_amdgcn_sched_barrier(0)
        const int s0 = dir ? 15 : 0, ds = dir ? -1 : 1;
        LD_H(A, s0, 0)
        SB();
#pragma unroll 1
        for (int s_ = 0; s_ < 16; ++s_) {
          const int s = s0 + ds * s_;
          const int sn = (s_ < 15) ? s + ds : s;
          f2v ska = {0.f, 0.f}, skb = {0.f, 0.f}, ya = {0.f, 0.f}, yb = {0.f, 0.f};
          const float vv = LV[s * RS + lane];
          const f2v vv2 = {vv, vv};
          LD_H(B, s, 1) SB(); CP_H(A, 0) SB();
          LD_K(A, s, 0) SB(); CP_H(B, 1) SB();
          const float sk = (ska.x + ska.y) + (skb.x + skb.y);
          const f2v nsk2 = {-sk, -sk};
          LD_K(B, s, 1) SB(); CP_K(A, 0) SB();
          LD_K(A, s, 2) SB(); CP_K(B, 1) SB();
          LD_K(B, s, 3) SB(); CP_K(A, 2) SB();
          LD_K(A, s, 4) SB(); CP_K(B, 3) SB();
          LD_K(B, s, 5) SB(); CP_K(A, 4) SB();
          LD_K(A, s, 6) SB(); CP_K(B, 5) SB();
          LD_K(B, s, 7) SB(); CP_K(A, 6) SB();
          LD_H(A, sn, 0) SB(); CP_K(B, 7) SB();
          LR[s * RS + lane] = (ya.x + ya.y) + (yb.x + yb.y);
        }
#undef LD_H
#undef LD_K
#undef CP_H
#undef CP_K
#undef SB
      }
      __syncthreads();
    }
    if (path == 0) {
      float* op = p.out + OUT_R + ((((size_t)(b * 2 + l) * 2 + dir) * 6 + h) * 64 + lane) * 64;
#pragma unroll
      for (int k4 = 0; k4 < 16; ++k4) {
        f4v v;
        v.xy = S[2 * k4]; v.zw = S[2 * k4 + 1];
        ((f4v*)op)[k4] = v;
      }
    }
  } else {
    bfu* Mb = p.HM + tok0 * DM + 384 + h * 64;
    {
      const float* mu0 = p.r_mu + l * 1408;
      PRM[lane] = mu0[h * 64 + lane];
      PRM[64 + lane] = mu0[384 + h * 64 + lane];
      PRM[128 + lane] = mu0[768 + h * 64 + lane];
      PRM[192 + lane] = mu0[1152 + dir * 64 + lane];
      PRM[256 + lane] = mu0[1280 + dir * 64 + lane];
      PRM[320 + lane] = p.r_rk[l * 384 + h * 64 + lane];
      PRM[384 + lane] = p.r_kk[l * 384 + h * 64 + lane];
      PRM[448 + lane] = p.r_ka[l * 384 + h * 64 + lane];
      PRM[512 + lane] = p.r_norm[l * 384 + h * 64 + lane];
      PRM[576 + lane] = p.r_w0[(l * 2 + dir) * 384 + h * 64 + lane];
      PRM[640 + lane] = p.r_a0[(l * 2 + dir) * 384 + h * 64 + lane];
    }
    if (wave < 4) {
      rwkv_prepA_iter(Ub, Mb, PRM, D, D, false, false, 0, true, (dir ? NT - 1 : 0) * 16, T, path, h, lane);
      __syncthreads();
#pragma unroll 1
      for (int it = 0; it <= NT; ++it) {
        const int kf = it - 1, kp = it + 1;
        rwkv_prepA_iter(Ub, Mb, PRM, D + (kf & 1) * RBUF, D + (kp & 1) * RBUF, it >= 1, kf < NT / 2, (dir ? NT - 1 - kf : kf) * 16,
                        kp < NT, (dir ? NT - 1 - kp : kp) * 16, T, path, h, lane);
        __syncthreads();
      }
    } else {
      const bf16x8* wf = (const bf16x8*)p.WF + ((size_t)((l * 2 + dir) * 6 + h) * 16) * 64 + lane;
      rwkv_prepB_tile(Ub, PRM, D, wf, (dir ? NT - 1 : 0) * 16, T, path, dir, h, lane);
      __syncthreads();
#pragma unroll 1
      for (int it = 0; it <= NT; ++it) {
        if (it + 1 < NT) {
          const int k = it + 1;
          rwkv_prepB_tile(Ub, PRM, D + (k & 1) * RBUF, wf, (dir ? NT - 1 - k : k) * 16, T, path, dir, h, lane);
        }
        __syncthreads();
      }
    }
  }
}

#define LS 72
__device__ void mlstm_job(const Params& p, int l, int path, int unit, int wv) {
  float* smem = SMEM;
  const int tid = opaque_tid(wv);
  const int wave = tid >> 6, lane = tid & 63;
  const int dir = wave >> 2, w = wave & 3, tg = tid & 255;
  const int b = unit / 6, h = unit % 6;
  const int T = path ? 2048 : 256, NC = T >> 6;
  const size_t tok0 = path ? (size_t)NTP + (size_t)b * 2048 : (size_t)b * 256;
  const bfu* Ub = p.U + tok0 * UC;
  bfu* Mb = p.HM + tok0 * DM + h * 64;
  bfu* base = (bfu*)smem + dir * (288 * LS);
  bfu *KWT = base, *VT = base + 64 * LS, *CT = base + 144 * LS, *P = base + 224 * LS;
  float* fb = smem + (2 * 288 * LS * 2) / 4 + dir * 272;
  float *X = fb, *MX = fb + 64, *BC = fb + 128, *WK = fb + 192, *SC = fb + 256;
  const int slot = lane & 15, g4 = lane >> 4;
  f32x4 C[5];
  float mstate = 0.f;
#pragma unroll
  for (int nt = 0; nt < 5; ++nt) C[nt] = (f32x4){0.f, 0.f, 0.f, 0.f};
  if (path) {
    const size_t sb = ((size_t)(b * 2 + l) * 2 + dir) * 6 + h;
    mstate = p.sm[sb];
#pragma unroll
    for (int nt = 0; nt < 4; ++nt)
#pragma unroll
      for (int i = 0; i < 4; ++i) C[nt][i] = p.sC[(sb * 64 + 16 * w + 4 * g4 + i) * 64 + nt * 16 + slot];
    if (slot == 0)
#pragma unroll
      for (int i = 0; i < 4; ++i) C[4][i] = p.sn[sb * 64 + 16 * w + 4 * g4 + i];
  }
  for (int i = tg; i < 16 * LS; i += 256) VT[64 * LS + i] = (i < 64) ? (bfu)0x3F80 : (bfu)0;
  const float bi = p.m_bi[l * 12 + dir * 6 + h], bff = p.m_bf[l * 12 + dir * 6 + h];
  __syncthreads();
  for (int ic = 0; ic < NC; ++ic) {
    const int ch = dir ? NC - 1 - ic : ic;
    const int c0t = ch * 64;
    if (w == 0) {
      const bfu* ur = Ub + (size_t)(c0t + lane) * UC;
      const float ip = bf2f(ur[UM_I + dir * 6 + h]) + bi;
      const float fp = bf2f(ur[UM_F + dir * 6 + h]) + bff;
      const float lf = fminf(fp, 0.f) - log1pf(__expf(-fabsf(fp)));
      float bs = lf;
      if (dir == 0) {
#pragma unroll
        for (int o = 1; o < 64; o <<= 1) { float v = bperm(lane - o, bs); if (lane >= o) bs += v; }
      } else {
#pragma unroll
        for (int o = 1; o < 64; o <<= 1) { float v = bperm(lane + o, bs); if (lane + o < 64) bs += v; }
      }
      const float x = ip - bs;
      float pm = x;
      if (dir == 0) {
#pragma unroll
        for (int o = 1; o < 64; o <<= 1) { float v = bperm(lane - o, pm); if (lane >= o) pm = fmaxf(pm, v); }
      } else {
#pragma unroll
        for (int o = 1; o < 64; o <<= 1) { float v = bperm(lane + o, pm); if (lane + o < 64) pm = fmaxf(pm, v); }
      }
      const int last = dir ? 0 : 63;
      const float pmtot = bperm(last, pm), bL = bperm(last, bs);
      const float mref = fmaxf(mstate, pmtot);
      X[lane] = x; MX[lane] = fmaxf(mstate, pm); BC[lane] = bs; WK[lane] = __expf(x - mref);
      if (lane == 0) { SC[0] = __expf(mstate - mref); SC[1] = bL + mref; }
    }
#pragma unroll
    for (int nt = 0; nt < 5; ++nt) {
      uint2 o;
      o.x = pack2(C[nt][0], C[nt][1]);
      o.y = pack2(C[nt][2], C[nt][3]);
      *(uint2*)(CT + (nt * 16 + slot) * LS + 16 * w + 4 * g4) = o;
    }
    __syncthreads();
    {
      const int s = tg >> 2, cq = (tg & 3) * 16;
      const bfu* ur = Ub + (size_t)(c0t + s) * UC + h * 64 + cq;
      float kf[16];
      ld8(ur + UM_K, kf); ld8(ur + UM_K + 8, kf + 8);
      const float sc = 0.125f * WK[s];
      const uint4 v0 = *(const uint4*)(ur + UM_V), v1 = *(const uint4*)(ur + UM_V + 8);
      const unsigned vv[8] = {v0.x, v0.y, v0.z, v0.w, v1.x, v1.y, v1.z, v1.w};
#pragma unroll
      for (int j = 0; j < 16; ++j) {
        KWT[(cq + j) * LS + s] = f2bf(kf[j] * sc);
        VT[(cq + j) * LS + s] = (bfu)((j & 1) ? (vv[j >> 1] >> 16) : (vv[j >> 1] & 0xffffu));
      }
    }
    bf16x8 aq[2];
    {
      const bfu* qp = Ub + (size_t)(c0t + 16 * w + slot) * UC + UM_Q + h * 64 + 8 * g4;
      aq[0] = *(const bf16x8*)qp;
      aq[1] = *(const bf16x8*)(qp + 32);
      f32x4 aS[4];
#pragma unroll
      for (int nt = 0; nt < 4; ++nt) {
        const bfu* kp = Ub + (size_t)(c0t + nt * 16 + slot) * UC + UM_K + h * 64 + 8 * g4;
        bf16x8 k0 = *(const bf16x8*)kp, k1 = *(const bf16x8*)(kp + 32);
        aS[nt] = (f32x4){0.f, 0.f, 0.f, 0.f};
        aS[nt] = __builtin_amdgcn_mfma_f32_16x16x32_bf16(aq[0], k0, aS[nt], 0, 0, 0);
        aS[nt] = __builtin_amdgcn_mfma_f32_16x16x32_bf16(aq[1], k1, aS[nt], 0, 0, 0);
      }
#pragma unroll
      for (int i = 0; i < 4; ++i) {
        const int t = 16 * w + 4 * g4 + i;
        const float mxt = MX[t];
#pragma unroll
        for (int nt = 0; nt < 4; ++nt) {
          const int s = nt * 16 + slot;
          const bool keep = dir ? (s >= t) : (s <= t);
          const float pv = keep ? aS[nt][i] * 0.125f * __expf(X[s] - mxt) : 0.f;
          P[t * LS + s] = f2bf(pv);
        }
      }
    }
    __syncthreads();
    f32x4 hv[4];
    {
      bf16x8 ap[2];
      const bfu* pp = P + (16 * w + slot) * LS + 8 * g4;
      ap[0] = *(const bf16x8*)pp; ap[1] = *(const bf16x8*)(pp + 32);
      f32x4 aC[5], aP[5];
#pragma unroll
      for (int nt = 0; nt < 5; ++nt) {
        aC[nt] = (f32x4){0.f, 0.f, 0.f, 0.f};
        aP[nt] = (f32x4){0.f, 0.f, 0.f, 0.f};
#pragma unroll
        for (int ks = 0; ks < 2; ++ks) {
          bf16x8 bc = *(const bf16x8*)(CT + (nt * 16 + slot) * LS + 32 * ks + 8 * g4);
          bf16x8 bv = *(const bf16x8*)(VT + (nt * 16 + slot) * LS + 32 * ks + 8 * g4);
          aC[nt] = __builtin_amdgcn_mfma_f32_16x16x32_bf16(aq[ks], bc, aC[nt], 0, 0, 0);
          aP[nt] = __builtin_amdgcn_mfma_f32_16x16x32_bf16(ap[ks], bv, aP[nt], 0, 0, 0);
        }
      }
#pragma unroll
      for (int i = 0; i < 4; ++i) {
        const int t = 16 * w + 4 * g4 + i;
        const float mxt = MX[t];
        const float sc = __expf(mstate - mxt);
        float den = sc * aC[4][i] + aP[4][i];
        den = bperm(lane & 48, den);
        const float lower = __expf(-(BC[t] + mxt));
        const float inv = 1.f / fmaxf(fabsf(den), lower);
#pragma unroll
        for (int nt = 0; nt < 4; ++nt) hv[nt][i] = (sc * aC[nt][i] + aP[nt][i]) * inv;
      }
    }
#pragma unroll
    for (int i = 0; i < 4; ++i) {
      const int t = c0t + 16 * w + 4 * g4 + i;
      bfu* mp = Mb + (size_t)t * DM;
      if (ic < NC / 2) {
#pragma unroll
        for (int nt = 0; nt < 4; ++nt) mp[nt * 16 + slot] = f2bf(hv[nt][i]);
      } else {
        float hh[4];
        float ss = 0.f;
#pragma unroll
        for (int nt = 0; nt < 4; ++nt) { hh[nt] = hv[nt][i] + bf2f(mp[nt * 16 + slot]); ss += hh[nt] * hh[nt]; }
        ss += shx<1>(ss); ss += shx<2>(ss); ss += shx<4>(ss); ss += shx<8>(ss);
        const float rstd = rsqrtf(ss * (1.f / 64.f) + EPSF);
        const bfu* ur = Ub + (size_t)t * UC + h * 64;
#pragma unroll
        for (int nt = 0; nt < 4; ++nt) {
          const int e = nt * 16 + slot;
          const float o = bf2f(ur[UM_O + e]), z = bf2f(ur[UM_Z + e]);
          mp[e] = f2bf(hh[nt] * rstd * p.m_norm[l * 384 + h * 64 + e] * sigm(o) * siluf(z));
        }
      }
    }
    {
      const float dec = SC[0];
      bf16x8 ak[2];
      const bfu* kp = KWT + (16 * w + slot) * LS + 8 * g4;
      ak[0] = *(const bf16x8*)kp; ak[1] = *(const bf16x8*)(kp + 32);
#pragma unroll
      for (int nt = 0; nt < 5; ++nt) {
        f32x4 aD = {0.f, 0.f, 0.f, 0.f};
#pragma unroll
        for (int ks = 0; ks < 2; ++ks) {
          bf16x8 bv = *(const bf16x8*)(VT + (nt * 16 + slot) * LS + 32 * ks + 8 * g4);
          aD = __builtin_amdgcn_mfma_f32_16x16x32_bf16(ak[ks], bv, aD, 0, 0, 0);
        }
#pragma unroll
        for (int i = 0; i < 4; ++i) C[nt][i] = dec * C[nt][i] + aD[i];
      }
      mstate = SC[1];
    }
    __syncthreads();
  }
  if (path == 0) {
    const size_t sb = ((size_t)(b * 2 + l) * 2 + dir) * 6 + h;
#pragma unroll
    for (int nt = 0; nt < 4; ++nt)
#pragma unroll
      for (int i = 0; i < 4; ++i) p.out[OUT_C + (sb * 64 + 16 * w + 4 * g4 + i) * 64 + nt * 16 + slot] = C[nt][i];
    if (slot == 0)
#pragma unroll
      for (int i = 0; i < 4; ++i) p.out[OUT_N + sb * 64 + 16 * w + 4 * g4 + i] = C[4][i];
    if (tg == 0) p.out[OUT_M + sb] = mstate;
  }
}

__device__ void lru_job(const Params& p, int l, int path, int unit, int wv) {
  float* smem = SMEM;
  const int tid = opaque_tid(wv);
  const int wave = tid >> 6, lane = tid & 63;
  const int dir = wave >> 2, w = wave & 3, tg = tid & 255;
  const int b = unit >> 2, n = unit & 3;
  const int T = path ? 2048 : 256, NT = T >> 6;
  const size_t tok0 = path ? (size_t)NTP + (size_t)b * 2048 : (size_t)b * 256;
  const bfu* Ub = p.U + tok0 * UC;
  bfu* Mb = p.HM + tok0 * DM + 768 + n * 64;
  unsigned char* sb_ = (unsigned char*)smem + dir * 41984;
  bfu* XC = (bfu*)sb_;
  float* AA = (float*)(sb_ + 9216);
  float* BB = AA + 4096;
  const int slot = lane & 15, g4 = lane >> 4;
  const bf16x8* lf = (const bf16x8*)p.LF + ((size_t)((l * 2 + dir) * 4 + n) * 16) * 64 + lane;
  float hstate = 0.f;
  if (path) hstate = p.sL[((size_t)(b * 2 + l) * 2 + dir) * 256 + n * 64 + lane];
  for (int it = 0; it < NT; ++it) {
    const int ti = dir ? NT - 1 - it : it;
    const int t0 = ti * 64;
    const int tl = tg >> 2, cq = (tg & 3) * 16;
    {
      const int t = t0 + tl;
      float acc[16];
#pragma unroll
      for (int j = 0; j < 16; ++j) acc[j] = p.l_conv_b[l * 256 + n * 64 + cq + j];
#pragma unroll
      for (int tap = 0; tap < 4; ++tap) {
        const int ts = t + tap - 2;
        const float wgt = (ts >= 0 && ts < T) ? 1.f : 0.f;
        const int tc = min(max(ts, 0), T - 1);
        float xv[16];
        const bfu* ur = Ub + (size_t)tc * UC + UL + n * 64 + cq;
        ld8(ur, xv); ld8(ur + 8, xv + 8);
#pragma unroll
        for (int j = 0; j < 16; ++j) acc[j] += wgt * xv[j] * p.l_conv[(l * 4 + tap) * 256 + n * 64 + cq + j];
      }
      *(uint4*)(XC + tl * LS + cq) = pack8(acc);
      *(uint4*)(XC + tl * LS + cq + 8) = pack8(acc + 8);
    }
    __syncthreads();
    {
      bf16x8 ax[2];
      const bfu* xp = XC + (16 * w + slot) * LS + 8 * g4;
      ax[0] = *(const bf16x8*)xp; ax[1] = *(const bf16x8*)(xp + 32);
#pragma unroll
      for (int nt = 0; nt < 4; ++nt) {
        f32x4 ga = {0.f, 0.f, 0.f, 0.f}, gx = {0.f, 0.f, 0.f, 0.f};
#pragma unroll
        for (int ks = 0; ks < 2; ++ks) {
          ga = __builtin_amdgcn_mfma_f32_16x16x32_bf16(ax[ks], lf[(nt * 2 + ks) * 64], ga, 0, 0, 0);
          gx = __builtin_amdgcn_mfma_f32_16x16x32_bf16(ax[ks], lf[(8 + nt * 2 + ks) * 64], gx, 0, 0, 0);
        }
        const int o = nt * 16 + slot;
        const int chn = (l * 2 + dir) * 256 + n * 64 + o;
        const float bav = p.l_ba[chn], bxv = p.l_bx[chn];
        const float lam = p.l_lambda[chn];
        const float sp = fmaxf(-lam, 0.f) + log1pf(__expf(-fabsf(lam)));
#pragma unroll
        for (int i = 0; i < 4; ++i) {
          const int t = 16 * w + 4 * g4 + i;
          const float rg = sigm(ga[i] + bav), ig = sigm(gx[i] + bxv);
          const float la = -8.f * rg * sp;
          const float a = __expf(la);
          const float bt = sqrtf(fmaxf(-expm1f(2.f * la), 0.f)) * ig * bf2f(XC[t * LS + o]);
          AA[t * 64 + o] = a;
          BB[t * 64 + o] = bt;
        }
      }
    }
    __syncthreads();
    if (w == 0) {
#pragma unroll 4
      for (int s_ = 0; s_ < 64; ++s_) {
        const int s = dir ? 63 - s_ : s_;
        hstate = AA[s * 64 + lane] * hstate + BB[s * 64 + lane];
        BB[s * 64 + lane] = hstate;
      }
    }
    __syncthreads();
    {
      const int t = t0 + tl;
      bfu* mp = Mb + (size_t)t * DM + cq;
      float y[16];
#pragma unroll
      for (int j = 0; j < 16; ++j) y[j] = BB[tl * 64 + cq + j];
      if (it >= NT / 2) {
        float pp[16], gz[16];
        ld8(mp, pp); ld8(mp + 8, pp + 8);
        const bfu* gp = Ub + (size_t)t * UC + ULZ + n * 64 + cq;
        ld8(gp, gz); ld8(gp + 8, gz + 8);
#pragma unroll
        for (int j = 0; j < 16; ++j) y[j] = (y[j] + pp[j]) * siluf(gz[j]);
      }
      *(uint4*)mp = pack8(y);
      *(uint4*)(mp + 8) = pack8(y + 8);
    }
    __syncthreads();
  }
  if (path == 0 && w == 0) p.out[OUT_L + ((size_t)(b * 2 + l) * 2 + dir) * 256 + n * 64 + lane] = hstate;
}

__device__ void phase_mix(const Params& p, int l, int wv) {
  __shared__ int sjob;
  for (;;) {
    if (wv == 0 && opaque_tid(0) == 0) sjob = (int)atomicAdd(&p.ctr[l], 1u);
    __syncthreads();
    const int job = __builtin_amdgcn_readfirstlane(sjob);
    __syncthreads();
    if (job >= 640) break;
    int type, path, idx;
    if (job < 48) { type = 0; path = 1; idx = job; }
    else if (job < 96) { type = 1; path = 1; idx = job - 48; }
    else if (job < 128) { type = 2; path = 1; idx = job - 96; }
    else if (job < 320) { type = 0; path = 0; idx = job - 128; }
    else if (job < 512) { type = 1; path = 0; idx = job - 320; }
    else { type = 2; path = 0; idx = job - 512; }
    if (type == 0) { if (PHM & 16) rwkv_job(p, l, path, idx, wv); }
    else if (type == 1) { if (PHM & 32) mlstm_job(p, l, path, idx, wv); }
    else { if (PHM & 64) lru_job(p, l, path, idx, wv); }
    __syncthreads();
    if (PROBE_SEL && wv == 0 && opaque_tid(0) == 0) {
      const int cat = job < 48 ? 0 : job < 96 ? 2 : job < 128 ? 3 : job < 320 ? 1 : job < 512 ? 4 : 5;
      atomicMax(&p.ts[16 + l * 8 + cat], (unsigned long long)wall_clock64());
    }
  }
}

template <bool USE_GRID>
__global__ void __launch_bounds__(NTHREADS) mega_kernel(Params p) {
  const int wv = __builtin_amdgcn_readfirstlane((int)(threadIdx.x >> 6));
  const int lo = (int)p.ph_lo, hi = (int)p.ph_hi;
  for (int ph = lo; ph < hi; ++ph) {
    if (ph == 0) { if (PHM & 1) phase_mod(p, wv); }
    else if (ph == 1) { if (PHM & 2) phase_h0(p, wv); }
    else {
      const int l = (ph - 2) / 3, s = (ph - 2) % 3;
      if (s == 0) { if (PHM & 4) phase_inproj(p, l, wv); }
      else if (s == 1) phase_mix(p, l, wv);
      else { if (PHM & 8) phase_outproj(p, l, wv); }
    }
    if constexpr (USE_GRID) {
      if (ph + 1 < hi || PROBE_SEL) cg::this_grid().sync();
    }
    if (PROBE_SEL && blockIdx.x == 0 && wv == 0 && opaque_tid(0) == 0) p.ts[ph + 1] = wall_clock64();

  }
  if (PROBE_SEL && blockIdx.x == 0 && wv == 0 && opaque_tid(0) == 0) {
    const unsigned long long tend = wall_clock64();
    unsigned long long d = 0;
    if (PROBE_SEL == 1) d = p.ts[2] - p.ts[1];
    else if (PROBE_SEL == 2) d = p.ts[3] - p.ts[2];
    else if (PROBE_SEL == 3) d = p.ts[4] - p.ts[3];
    else if (PROBE_SEL == 4) d = p.ts[5] - p.ts[4];
    else if (PROBE_SEL >= 5 && PROBE_SEL <= 10) d = p.ts[16 + PROBE_SEL - 5] - p.ts[3];
    else if (PROBE_SEL == 11) d = p.ts[8] - p.ts[7];
    while ((unsigned long long)wall_clock64() - tend < PROBE_MULT * d) asm volatile("s_sleep 2");
  }
}

extern "C" void kernel_launch(void* const* d_in, const int* in_sizes, int n_in, void* d_out, int out_size, void* d_ws,
                              size_t ws_size, hipStream_t stream) {
  static int grid = 0;
  if (grid == 0) {
    if (n_in != 34 || ws_size < WS_END) {
      fprintf(stderr, "kernel_launch: unexpected n_in %d or ws_size %zu (< %llu)\n", n_in, ws_size, WS_END);
      grid = -1;
      return;
    }
    int dev = 0, cus = 0, per_cu = 0;
    hipGetDevice(&dev);
    hipDeviceGetAttribute(&cus, hipDeviceAttributeMultiprocessorCount, dev);
#if COOP
    hipFuncSetAttribute((const void*)mega_kernel<true>, hipFuncAttributeMaxDynamicSharedMemorySize, LDS_BYTES);
    hipOccupancyMaxActiveBlocksPerMultiprocessor(&per_cu, (const void*)mega_kernel<true>, NTHREADS, LDS_BYTES);
#else
    hipFuncSetAttribute((const void*)mega_kernel<false>, hipFuncAttributeMaxDynamicSharedMemorySize, LDS_BYTES);
    hipOccupancyMaxActiveBlocksPerMultiprocessor(&per_cu, (const void*)mega_kernel<false>, NTHREADS, LDS_BYTES);
#endif
    if (per_cu < 1) { fprintf(stderr, "kernel_launch: occupancy query returned %d\n", per_cu); per_cu = 1; }
    if (per_cu > 1) per_cu = 1;
    grid = cus * per_cu;
  }
  if (grid < 0) return;
  Params p{};
  const float** pf = (const float**)&p;
  for (int i = 0; i < 34; ++i) pf[i] = (const float*)d_in[i];
  p.out = (float*)d_out;
  p.U = (bfu*)((char*)d_ws + WS_U);
  p.HM = (bfu*)((char*)d_ws + WS_HM);
  p.MOD = (float*)((char*)d_ws + WS_MOD);
  p.ctr = (unsigned int*)((char*)d_ws + WS_CTR);
  p.WF = (bfu*)((char*)d_ws + WS_WF);
  p.LF = (bfu*)((char*)d_ws + WS_LF);
  p.ts = (unsigned long long*)((char*)d_ws + WS_TS);
#if COOP
  p.ph_lo = 0; p.ph_hi = 8;
  void* args[] = {&p};
  hipError_t e = hipLaunchCooperativeKernel((const void*)mega_kernel<true>, dim3(grid), dim3(NTHREADS), args, LDS_BYTES, stream);
  if (e != hipSuccess) fprintf(stderr, "cooperative launch failed: %s (grid %d)\n", hipGetErrorString(e), grid);
#else
  for (int ph = 0; ph < 8; ++ph) {
    p.ph_lo = ph; p.ph_hi = ph + 1;
    hipLaunchKernelGGL(mega_kernel<false>, dim3(grid), dim3(NTHREADS), LDS_BYTES, stream, p);
  }
#endif
}
```

```cpp
#include <hip/hip_runtime.h>
#include <hip/hip_cooperative_groups.h>
#include <cstdio>
namespace cg = cooperative_groups;

#ifndef COOP
#define COOP 1
#endif

typedef __attribute__((ext_vector_type(8))) short bf16x8;
typedef __attribute__((ext_vector_type(4))) float f32x4;
typedef unsigned short bfu;
typedef float f2v __attribute__((ext_vector_type(2)));
typedef float f4v __attribute__((ext_vector_type(4)));

#define NTOK 24576
#define NTP 8192
#define DM 1024
#define UC 4248
#define EPSF 1e-6f
#define UM_Q 0
#define UM_K 384
#define UM_V 768
#define UM_O 1152
#define UM_Z 1536
#define UM_I 1920
#define UM_F 1932
#define UR 1944
#define URZ 3352
#define UL 3736
#define ULZ 3992

#define OUT_Y 0
#define OUT_C 25165824
#define OUT_N 28311552
#define OUT_M 28360704
#define OUT_R 28361472
#define OUT_L 31507200

#define WS_U 0ull
#define WS_HM 208797696ull
#define WS_MOD 259129344ull
#define WS_CTR 259350528ull
#define WS_WF 259350784ull
#define WS_LF 259744000ull
#define WS_END 260006144ull

#ifndef PHM
#define PHM 127
#endif
#ifndef PROBE_SEL
#define PROBE_SEL 0
#endif
#define PROBE_MULT 4
#define WS_TS 260006144ull
#define LDS_BYTES 116736
#define NTHREADS 512

extern __shared__ __attribute__((aligned(16))) unsigned char lds_raw[];
#define SMEM ((float*)lds_raw)

struct Params {
  const float *x_prompt, *x_sample, *c, *sC, *sn, *sm, *sR, *sL, *c_ctx, *g_pre, *g_post, *w_mod, *b_mod, *w_in, *w_out,
      *m_bi, *m_bf, *m_norm, *r_mu, *r_w0, *r_w2, *r_a0, *r_a2, *r_kk, *r_ka, *r_rk, *r_norm, *l_conv, *l_conv_b, *l_wa,
      *l_ba, *l_wx, *l_bx, *l_lambda;
  float* out;
  bfu* U;
  bfu* HM;
  float* MOD;
  unsigned int* ctr;
  bfu* WF;
  bfu* LF;
  unsigned long long* ts;
  long long ph_lo, ph_hi;
};

__device__ __forceinline__ int opaque_tid(int wv) {
  int ln = __builtin_amdgcn_mbcnt_hi(~0u, __builtin_amdgcn_mbcnt_lo(~0u, 0u));
  asm volatile("" : "+v"(ln));
  return wv * 64 + ln;
}
template <int M>
__device__ __forceinline__ float shx(float v) {
  return __builtin_bit_cast(float, __builtin_amdgcn_ds_swizzle(__builtin_bit_cast(int, v), (M << 10) | 0x1F));
}
__device__ __forceinline__ float bperm(int srclane, float v) {
  return __builtin_bit_cast(float, __builtin_amdgcn_ds_bpermute(srclane << 2, __builtin_bit_cast(int, v)));
}
__device__ __forceinline__ bfu f2bf(float f) { return __builtin_bit_cast(bfu, (__bf16)f); }
__device__ __forceinline__ float bf2f(bfu h) { return __uint_as_float(((unsigned)h) << 16); }
typedef __bf16 bf2v __attribute__((ext_vector_type(2)));
__device__ __forceinline__ unsigned pack2(float a, float b) {
  const f2v v = {a, b};
  return __builtin_bit_cast(unsigned, __builtin_convertvector(v, bf2v));
}
__device__ __forceinline__ float sigm(float x) { return __builtin_amdgcn_rcpf(1.f + __expf(-x)); }
__device__ __forceinline__ float siluf(float x) { return x * __builtin_amdgcn_rcpf(1.f + __expf(-x)); }
__device__ __forceinline__ void unpack8(uint4 v, float* f) {
  f[0] = __uint_as_float(v.x << 16); f[1] = __uint_as_float(v.x & 0xffff0000u);
  f[2] = __uint_as_float(v.y << 16); f[3] = __uint_as_float(v.y & 0xffff0000u);
  f[4] = __uint_as_float(v.z << 16); f[5] = __uint_as_float(v.z & 0xffff0000u);
  f[6] = __uint_as_float(v.w << 16); f[7] = __uint_as_float(v.w & 0xffff0000u);
}
__device__ __forceinline__ void ld8(const bfu* p, float* f) { unpack8(*(const uint4*)p, f); }
__device__ __forceinline__ void ld8acc(const bfu* p, float* f) {
  float t[8]; unpack8(*(const uint4*)p, t);
#pragma unroll
  for (int j = 0; j < 8; ++j) f[j] += t[j];
}
__device__ __forceinline__ uint4 pack8(const float* f) {
  uint4 v; v.x = pack2(f[0], f[1]); v.y = pack2(f[2], f[3]); v.z = pack2(f[4], f[5]); v.w = pack2(f[6], f[7]);
  return v;
}
struct ShW { int tm1, tp1, tmd, tpd; float wm1, wp1, wmd, wpd; };
struct Sh5 { uint4 r0, r1, r2, r3, r4; };
__device__ __forceinline__ ShW shift_weights(int t, int T, int path) {
  ShW w;
  const int d = path ? 64 : 1;
  const float cf = path ? 0.25f : 0.5f;
  w.tm1 = max(t - 1, 0); w.tp1 = min(t + 1, T - 1); w.tmd = max(t - d, 0); w.tpd = min(t + d, T - 1);
  w.wm1 = (path ? (t & 63) > 0 : t > 0) ? cf : 0.f;
  w.wp1 = (path ? (t & 63) < 63 : t < T - 1) ? cf : 0.f;
  w.wmd = (path && t >= 64) ? cf : 0.f;
  w.wpd = (path && t < T - 64) ? cf : 0.f;
  return w;
}
__device__ __forceinline__ void shift_issue(const bfu* Ub, int t, const ShW& w, Sh5& o) {
  o.r0 = *(const uint4*)(Ub + (size_t)t * UC);
  o.r1 = *(const uint4*)(Ub + (size_t)w.tm1 * UC);
  o.r2 = *(const uint4*)(Ub + (size_t)w.tp1 * UC);
  o.r3 = *(const uint4*)(Ub + (size_t)w.tmd * UC);
  o.r4 = *(const uint4*)(Ub + (size_t)w.tpd * UC);
}
__device__ __forceinline__ void shift_finish(const Sh5& o, const ShW& w, const float* mu, float* blk) {
  float u[8], a[8];
  unpack8(o.r0, u);
  unpack8(o.r1, a);
  float sh[8];
#pragma unroll
  for (int j = 0; j < 8; ++j) sh[j] = w.wm1 * a[j];
  unpack8(o.r2, a);
#pragma unroll
  for (int j = 0; j < 8; ++j) sh[j] += w.wp1 * a[j];
  unpack8(o.r3, a);
#pragma unroll
  for (int j = 0; j < 8; ++j) sh[j] += w.wmd * a[j];
  unpack8(o.r4, a);
#pragma unroll
  for (int j = 0; j < 8; ++j) sh[j] += w.wpd * a[j];
#pragma unroll
  for (int j = 0; j < 8; ++j) blk[j] = u[j] + mu[j] * (sh[j] - u[j]);
}

__device__ void phase_mod(const Params& p, int wv) {
  float* smem = SMEM;
  const int tid = opaque_tid(wv);
  if (blockIdx.x == 0 && tid < 8) p.ctr[tid] = 0u;
  if (PROBE_SEL && blockIdx.x == 0 && tid < 64) p.ts[tid] = 0ull;
  for (int idx = blockIdx.x * NTHREADS + tid; idx < 24576 + 16384; idx += gridDim.x * NTHREADS) {
    float f[8];
    if (idx < 24576) {
      const int ln = idx & 63, fr = (idx >> 6) & 7, mat = (idx >> 9) & 1, hd = idx >> 10;
      const int h = hd % 6, ld = hd / 6, nt = fr >> 1, ks = fr & 1;
      const float* src = mat ? p.r_a2 : p.r_w2;
#pragma unroll
      for (int j = 0; j < 8; ++j) f[j] = src[((size_t)ld * 64 + 8 * (ln >> 4) + j + 32 * ks) * 384 + h * 64 + nt * 16 + (ln & 15)];
      *(uint4*)(p.WF + (size_t)idx * 8) = pack8(f);
    } else {
      const int id2 = idx - 24576;
      const int ln = id2 & 63, fr = (id2 >> 6) & 7, mat = (id2 >> 9) & 1, ldn = id2 >> 10;
      const int nt = fr >> 1, ks = fr & 1;
      const float* src = mat ? p.l_wx : p.l_wa;
#pragma unroll
      for (int j = 0; j < 8; ++j) f[j] = src[((size_t)ldn * 64 + 8 * (ln >> 4) + j + 32 * ks) * 64 + nt * 16 + (ln & 15)];
      *(uint4*)(p.LF + (size_t)id2 * 8) = pack8(f);
    }
  }
  for (int i = tid; i < 9 * 1024; i += NTHREADS) {
    int v = i >> 10, k = i & 1023;
    float cv = (v == 0) ? p.c_ctx[k] : p.c[(v - 1) * 1024 + k];
    smem[i] = siluf(cv);
  }
  __syncthreads();
  float* red = smem + 9 * 1024;
  const int col = tid & 31, kg = tid >> 5;
  for (int chunk = blockIdx.x; chunk < 192; chunk += gridDim.x) {
    const int l = chunk / 96, n0 = (chunk % 96) * 32;
    const float* w = p.w_mod + (size_t)l * 1024 * 3072 + n0 + col;
    float acc[9];
#pragma unroll
    for (int v = 0; v < 9; ++v) acc[v] = 0.f;
    for (int k = kg * 64; k < kg * 64 + 64; ++k) {
      float wv = w[(size_t)k * 3072];
#pragma unroll
      for (int v = 0; v < 9; ++v) acc[v] += smem[v * 1024 + k] * wv;
    }
#pragma unroll
    for (int v = 0; v < 9; ++v) red[(kg * 9 + v) * 32 + col] = acc[v];
    __syncthreads();
    if (tid < 288) {
      int v = tid >> 5;
      float s = 0.f;
      for (int g = 0; g < 16; ++g) s += red[(g * 9 + v) * 32 + col];
      p.MOD[(size_t)(l * 9 + v) * 3072 + n0 + col] = s + p.b_mod[l * 3072 + n0 + col];
    }
    __syncthreads();
  }
}

__device__ __forceinline__ int modvec(int row) { return row < NTP ? 0 : 1 + ((row - NTP) >> 11); }

__device__ void phase_h0(const Params& p, int wv) {
  const int tid = opaque_tid(wv);
  const int wave = tid >> 6, lane = tid & 63;
  for (int row = blockIdx.x * 8 + wave; row < NTOK; row += gridDim.x * 8) {
    const float* xr = row < NTP ? p.x_prompt + (size_t)row * DM : p.x_sample + (size_t)(row - NTP) * DM;
    float4 v[4];
    float ss = 0.f;
#pragma unroll
    for (int j = 0; j < 4; ++j) {
      v[j] = ((const float4*)xr)[lane + 64 * j];
      ss += v[j].x * v[j].x + v[j].y * v[j].y + v[j].z * v[j].z + v[j].w * v[j].w;
    }
    ss += shx<1>(ss); ss += shx<2>(ss); ss += shx<4>(ss); ss += shx<8>(ss); ss += shx<16>(ss);
    ss = __builtin_amdgcn_readlane(ss, 0) + __builtin_amdgcn_readlane(ss, 32);
    const float rstd = rsqrtf(ss * (1.f / 1024.f) + EPSF);
    const float* md = p.MOD + (size_t)modvec(row) * 3072;
#pragma unroll
    for (int j = 0; j < 4; ++j) {
      const int k = (lane + 64 * j) * 4;
      float4 g = *(const float4*)(p.g_pre + k);
      float4 sh = *(const float4*)(md + k);
      float4 sc = *(const float4*)(md + 1024 + k);
      uint2 o;
      o.x = pack2(v[j].x * rstd * g.x * (1.f + sc.x) + sh.x, v[j].y * rstd * g.y * (1.f + sc.y) + sh.y);
      o.y = pack2(v[j].z * rstd * g.z * (1.f + sc.z) + sh.z, v[j].w * rstd * g.w * (1.f + sc.w) + sh.w);
      *(uint2*)(p.HM + (size_t)row * DM + k) = o;
    }
  }
}

#define LDK 40
__device__ __forceinline__ int ldsrow(int n) { return (n & ~63) | ((n & 3) << 4) | ((n >> 2) & 15); }

typedef unsigned int u4v __attribute__((ext_vector_type(4)));
template <int BM, int BN, int WM, int WN, int KR>
__device__ __forceinline__ void gemm_mainloop(const bfu* __restrict__ A, const float* __restrict__ B, int ldb, int n0,
                                              int nvalid, bfu* As, bfu* Bs, f32x4 (&acc)[BM / WM / 16][BN / WN / 16], const int tid) {
  constexpr int TM = BM / WM / 16, TN = BN / WN / 16;
  constexpr int NA = (BM * 4 + NTHREADS - 1) / NTHREADS;
  constexpr int NBU = (32 / KR) * (BN / 4) / NTHREADS;
  static_assert(NBU >= 1, "tile too small");
  const int wave = tid >> 6, lane = tid & 63;
  const int wm = wave / WN, wn = wave % WN;
  const int mbase = wm * (BM / WM), nbase = wn * (BN / WN);
#pragma unroll
  for (int i = 0; i < TM; ++i)
#pragma unroll
    for (int j = 0; j < TN; ++j) acc[i][j] = (f32x4){0.f, 0.f, 0.f, 0.f};

  const __amdgpu_buffer_rsrc_t rsrc = __builtin_amdgcn_make_buffer_rsrc((void*)B, 0, 1024 * ldb * 4, 0x00020000);
  uint4 ra[NA];
  f4v rb[NBU][KR];
#pragma unroll
  for (int j = 0; j < NA; ++j) ra[j] = make_uint4(0u, 0u, 0u, 0u);

#define G_LOADA(ks_)                                                                                        \
  _Pragma("unroll") for (int j = 0; j < NA; ++j) {                                                          \
    const int c = tid + NTHREADS * j;                                                                       \
    if (c < BM * 4) ra[j] = *(const uint4*)(A + (size_t)(c >> 2) * DM + (ks_) * 32 + (c & 3) * 8);          \
  }
#define G_STOREA()                                                                                          \
  _Pragma("unroll") for (int j = 0; j < NA; ++j) {                                                          \
    const int c = tid + NTHREADS * j;                                                                       \
    if (c < BM * 4) *(uint4*)(As + (c >> 2) * LDK + (c & 3) * 8) = ra[j];                                   \
  }
#define G_LOADB(ks_)                                                                                        \
  _Pragma("unroll") for (int j = 0; j < NBU; ++j) {                                                         \
    const int u = tid + NTHREADS * j;                                                                       \
    const int n4 = u % (BN / 4), kq = u / (BN / 4);                                                         \
    const unsigned voff = (4 * n4 < nvalid) ? (unsigned)((kq * KR * ldb + n0 + 4 * n4) * 4) : 0x80000000u;  \
    _Pragma("unroll") for (int r = 0; r < KR; ++r) rb[j][r] = __builtin_bit_cast(                           \
        f4v, __builtin_amdgcn_raw_buffer_load_b128(rsrc, voff, (unsigned)(((ks_) * 32 + r) * ldb * 4), 0)); \
  }
#define G_STOREB()                                                                                          \
  _Pragma("unroll") for (int j = 0; j < NBU; ++j) {                                                         \
    const int u = tid + NTHREADS * j;                                                                       \
    const int n4 = u % (BN / 4), kq = u / (BN / 4);                                                         \
    const int rowb = ((4 * n4) & ~63) | (n4 & 15);                                                          \
    _Pragma("unroll") for (int e = 0; e < 4; ++e) {                                                         \
      bfu* dst = Bs + (rowb | (e << 4)) * LDK + kq * KR;                                                    \
      if (KR == 8) {                                                                                        \
        uint4 pk;                                                                                           \
        pk.x = pack2(rb[j][0][e], rb[j][1][e]); pk.y = pack2(rb[j][2][e], rb[j][3][e]);                     \
        pk.z = pack2(rb[j][4 % KR][e], rb[j][5 % KR][e]); pk.w = pack2(rb[j][6 % KR][e], rb[j][7 % KR][e]); \
        *(uint4*)dst = pk;                                                                                  \
      } else {                                                                                              \
        uint2 pk;                                                                                           \
        pk.x = pack2(rb[j][0][e], rb[j][1][e]); pk.y = pack2(rb[j][2][e], rb[j][3][e]);                     \
        *(uint2*)dst = pk;                                                                                  \
      }                                                                                                     \
    }                                                                                                       \
  }

  G_LOADA(0)
  G_LOADB(0)
#pragma unroll 1
  for (int ks = 0; ks < 32; ++ks) {
    G_STOREA()
    G_STOREB()
    __syncthreads();
    if (ks + 1 < 32) {
      G_LOADA(ks + 1)
      G_LOADB(ks + 1)
    }
    bf16x8 af[TM];
#pragma unroll
    for (int i = 0; i < TM; ++i) af[i] = *(const bf16x8*)(As + (mbase + i * 16 + (lane & 15)) * LDK + (lane >> 4) * 8);
#pragma unroll
    for (int j = 0; j < TN; ++j) {
      const bf16x8 bfr = *(const bf16x8*)(Bs + (nbase + j * 16 + (lane & 15)) * LDK + (lane >> 4) * 8);
#pragma unroll
      for (int i = 0; i < TM; ++i) acc[i][j] = __builtin_amdgcn_mfma_f32_16x16x32_bf16(af[i], bfr, acc[i][j], 0, 0, 0);
    }
    __syncthreads();
  }
#undef G_LOADA
#undef G_STOREA
#undef G_LOADB
#undef G_STOREB
}

__device__ void phase_inproj(const Params& p, int l, int wv) {
  float* smem = SMEM;
  bfu* As = (bfu*)smem;
  bfu* Bs = As + 256 * LDK;
  const int tid = opaque_tid(wv);
  const int wave = tid >> 6, lane = tid & 63;
  const int wm = wave >> 2, wn = wave & 3;
  for (int tile = blockIdx.x; tile < 96 * 17; tile += gridDim.x) {
    const int m0 = (tile / 17) * 256, n0 = (tile % 17) * 256;
    const int nvalid = min(256, UC - n0);
    f32x4 acc[8][4];
    gemm_mainloop<256, 256, 2, 4, 4>(p.HM + (size_t)m0 * DM, p.w_in + (size_t)l * DM * UC, UC, n0, nvalid, As, Bs, acc, tid);
    const int slot = lane & 15, g4 = lane >> 4;
    const int c = n0 + wn * 64 + 4 * slot;
    if (c < UC) {
#pragma unroll
      for (int mt = 0; mt < 8; ++mt)
#pragma unroll
        for (int i = 0; i < 4; ++i) {
          const int row = m0 + wm * 128 + mt * 16 + 4 * g4 + i;
          uint2 o;
          o.x = pack2(acc[mt][0][i], acc[mt][1][i]);
          o.y = pack2(acc[mt][2][i], acc[mt][3][i]);
          *(uint2*)(p.U + (size_t)row * UC + c) = o;
        }
    }
  }
}

__device__ void phase_outproj(const Params& p, int l, int wv) {
  float* smem = SMEM;
  bfu* As = (bfu*)smem;
  bfu* Bs = As + 32 * LDK;
  float* red = (float*)(Bs + 1024 * LDK);
  float* rs = red + 256;
  const int tid = opaque_tid(wv);
  const int wave = tid >> 6, lane = tid & 63;
  const int slot = lane & 15, g4 = lane >> 4;
  for (int tile = blockIdx.x; tile < NTOK / 32; tile += gridDim.x) {
    const int m0 = tile * 32;
    f32x4 acc[2][8];
    gemm_mainloop<32, 1024, 1, 8, 8>(p.HM + (size_t)m0 * DM, p.w_out + (size_t)l * DM * DM, DM, 0, DM, As, Bs, acc, tid);
#pragma unroll
    for (int mt = 0; mt < 2; ++mt)
#pragma unroll
      for (int i = 0; i < 4; ++i) {
        float s = 0.f;
#pragma unroll
        for (int nt = 0; nt < 8; ++nt) s += acc[mt][nt][i] * acc[mt][nt][i];
        s += shx<1>(s); s += shx<2>(s); s += shx<4>(s); s += shx<8>(s);
        if (slot == 0) red[wave * 32 + mt * 16 + 4 * g4 + i] = s;
      }
    __syncthreads();
    if (tid < 32) {
      float s = 0.f;
      for (int w = 0; w < 8; ++w) s += red[w * 32 + tid];
      rs[tid] = rsqrtf(s * (1.f / 1024.f) + EPSF);
    }
    __syncthreads();
    const int vec = modvec(m0);
    const float* md = p.MOD + (size_t)(l * 9 + vec) * 3072;
#pragma unroll
    for (int mt = 0; mt < 2; ++mt)
#pragma unroll
      for (int i = 0; i < 4; ++i) {
        const int rl = mt * 16 + 4 * g4 + i;
        const int row = m0 + rl;
        const float rstd = rs[rl];
        const float* xin = (l == 0) ? (row < NTP ? p.x_prompt + (size_t)row * DM : p.x_sample + (size_t)(row - NTP) * DM)
                                    : p.out + OUT_Y + (size_t)row * DM;
#pragma unroll
        for (int q = 0; q < 2; ++q) {
          const int c = wave * 128 + 64 * q + 4 * slot;
          float4 xi = *(const float4*)(xin + c);
          float4 gt = *(const float4*)(md + 2048 + c);
          float4 gp = *(const float4*)(p.g_post + l * DM + c);
          float4 xn;
          xn.x = xi.x + gt.x * (acc[mt][4 * q + 0][i] * rstd * gp.x);
          xn.y = xi.y + gt.y * (acc[mt][4 * q + 1][i] * rstd * gp.y);
          xn.z = xi.z + gt.z * (acc[mt][4 * q + 2][i] * rstd * gp.z);
          xn.w = xi.w + gt.w * (acc[mt][4 * q + 3][i] * rstd * gp.w);
          *(float4*)(p.out + OUT_Y + (size_t)row * DM + c) = xn;
          acc[mt][4 * q + 0][i] = xn.x; acc[mt][4 * q + 1][i] = xn.y; acc[mt][4 * q + 2][i] = xn.z; acc[mt][4 * q + 3][i] = xn.w;
        }
        __builtin_amdgcn_sched_barrier(0);
      }
    if (l == 0) {
      __syncthreads();
#pragma unroll
      for (int mt = 0; mt < 2; ++mt)
#pragma unroll
        for (int i = 0; i < 4; ++i) {
          float s = 0.f;
#pragma unroll
          for (int nt = 0; nt < 8; ++nt) s += acc[mt][nt][i] * acc[mt][nt][i];
          s += shx<1>(s); s += shx<2>(s); s += shx<4>(s); s += shx<8>(s);
          if (slot == 0) red[wave * 32 + mt * 16 + 4 * g4 + i] = s;
        }
      __syncthreads();
      if (tid < 32) {
        float s = 0.f;
        for (int w = 0; w < 8; ++w) s += red[w * 32 + tid];
        rs[tid] = rsqrtf(s * (1.f / 1024.f) + EPSF);
      }
      __syncthreads();
      const float* md1 = p.MOD + (size_t)(9 + vec) * 3072;
#pragma unroll
      for (int mt = 0; mt < 2; ++mt)
#pragma unroll
        for (int i = 0; i < 4; ++i) {
          const int rl = mt * 16 + 4 * g4 + i;
          const int row = m0 + rl;
          const float rstd = rs[rl];
#pragma unroll
          for (int q = 0; q < 2; ++q) {
            const int c = wave * 128 + 64 * q + 4 * slot;
            float4 g = *(const float4*)(p.g_pre + DM + c);
            float4 sh = *(const float4*)(md1 + c);
            float4 sc = *(const float4*)(md1 + 1024 + c);
            uint2 o;
            o.x = pack2(acc[mt][4 * q + 0][i] * rstd * g.x * (1.f + sc.x) + sh.x, acc[mt][4 * q + 1][i] * rstd * g.y * (1.f + sc.y) + sh.y);
            o.y = pack2(acc[mt][4 * q + 2][i] * rstd * g.z * (1.f + sc.z) + sh.z, acc[mt][4 * q + 3][i] * rstd * g.w * (1.f + sc.w) + sh.w);
            *(uint2*)(p.HM + (size_t)row * DM + c) = o;
          }
          __builtin_amdgcn_sched_barrier(0);
        }
    }
    __syncthreads();
  }
}

#define RS 68
#define RBUF (6 * 16 * RS + 16)

__device__ __forceinline__ void rwkv_prepA_iter(const bfu* Ub, bfu* Mb, const float* PRM, const float* fbuf, float* pbuf, bool do_fin,
                                                bool first_half, int ft0, bool do_prep, int pt0, int T, int path, int h, int lane) {
  const int tl = lane >> 2, c0 = (lane & 3) * 16;
  f4v y4[4], v4[4];
  uint4 pp0, pp1, gz0, gz1;
  float bonf = 0.f;
  bfu* mp = Mb + (size_t)(ft0 + tl) * DM + c0;
  pp0 = pp1 = gz0 = gz1 = make_uint4(0u, 0u, 0u, 0u);
#pragma unroll
  for (int j4 = 0; j4 < 4; ++j4) { y4[j4] = (f4v){0.f, 0.f, 0.f, 0.f}; v4[j4] = (f4v){0.f, 0.f, 0.f, 0.f}; }
  if (do_fin) {
    const float *LR = fbuf, *LV = fbuf + 16 * RS, *BON = fbuf + 96 * RS;
#pragma unroll
    for (int j4 = 0; j4 < 4; ++j4) {
      y4[j4] = *(const f4v*)(LR + tl * RS + c0 + 4 * j4);
      v4[j4] = *(const f4v*)(LV + tl * RS + c0 + 4 * j4);
    }
    bonf = BON[tl];
    if (!first_half) {
      pp0 = *(const uint4*)mp; pp1 = *(const uint4*)(mp + 8);
      const bfu* gp = Ub + (size_t)(ft0 + tl) * UC + URZ + h * 64 + c0;
      gz0 = *(const uint4*)gp; gz1 = *(const uint4*)(gp + 8);
    }
  }
  __builtin_amdgcn_sched_barrier(0);
  if (do_prep) {
    float *LR = pbuf, *LV = pbuf + 16 * RS, *BON = pbuf + 96 * RS;
    const int t = pt0 + tl;
    const ShW sw = shift_weights(t, T, path);
    float part = 0.f;
#pragma unroll
    for (int hh = 0; hh < 2; ++hh) {
      const int cl = c0 + hh * 8;
      Sh5 lr, lk, lv;
      shift_issue(Ub + UR + h * 64 + cl, t, sw, lr);
      shift_issue(Ub + UR + 384 + h * 64 + cl, t, sw, lk);
      shift_issue(Ub + UR + 768 + h * 64 + cl, t, sw, lv);
      __builtin_amdgcn_sched_barrier(0);
      float rr[8], kk[8];
      shift_finish(lr, sw, PRM + cl, rr);
      *(f4v*)(LR + tl * RS + cl) = (f4v){rr[0], rr[1], rr[2], rr[3]};
      *(f4v*)(LR + tl * RS + cl + 4) = (f4v){rr[4], rr[5], rr[6], rr[7]};
      __builtin_amdgcn_sched_barrier(0);
      shift_finish(lk, sw, PRM + 64 + cl, kk);
#pragma unroll
      for (int j = 0; j < 8; ++j) part += rr[j] * kk[j] * PRM[320 + cl + j];
      __builtin_amdgcn_sched_barrier(0);
      shift_finish(lv, sw, PRM + 128 + cl, rr);
      *(f4v*)(LV + tl * RS + cl) = (f4v){rr[0], rr[1], rr[2], rr[3]};
      *(f4v*)(LV + tl * RS + cl + 4) = (f4v){rr[4], rr[5], rr[6], rr[7]};
      __builtin_amdgcn_sched_barrier(0);
    }
    part += shx<1>(part);
    part += shx<2>(part);
    BON[tl] = part;
  }
  __builtin_amdgcn_sched_barrier(0);
  if (do_fin) {
    float y[16];
#pragma unroll
    for (int j4 = 0; j4 < 4; ++j4) { y[4 * j4] = y4[j4][0]; y[4 * j4 + 1] = y4[j4][1]; y[4 * j4 + 2] = y4[j4][2]; y[4 * j4 + 3] = y4[j4][3]; }
    if (!first_half) {
      float pp[16], gz[16];
      unpack8(pp0, pp); unpack8(pp1, pp + 8);
      unpack8(gz0, gz); unpack8(gz1, gz + 8);
      float ss = 0.f;
#pragma unroll
      for (int j = 0; j < 16; ++j) { y[j] += pp[j]; ss += y[j] * y[j]; }
      ss += shx<1>(ss);
      ss += shx<2>(ss);
      const float rstd = rsqrtf(ss * (1.f / 64.f) + EPSF);
#pragma unroll
      for (int j = 0; j < 16; ++j) {
        float o = y[j] * rstd * PRM[512 + c0 + j] + bonf * v4[j >> 2][j & 3];
        y[j] = o * siluf(gz[j]);
      }
    }
    *(uint4*)mp = pack8(y);
    *(uint4*)(mp + 8) = pack8(y + 8);
  }
}
__device__ __forceinline__ void rwkv_prepB_tile(const bfu* Ub, const float* PRM, float* buf, const bf16x8* wf, int t0, int T, int path,
                                                int dir, int h, int lane) {
  float *LKH = buf + 32 * RS, *LW = buf + 48 * RS, *LB = buf + 64 * RS, *LKT = buf + 80 * RS;
  const int tl = lane >> 2, c0 = (lane & 3) * 16;
  const int slot = lane & 15, g4 = lane >> 4;
  {
    const int t = t0 + slot;
    bf16x8 awl[2], aal[2];
    const ShW sw = shift_weights(t, T, path);
    Sh5 lw0, lw1, la0, la1;
    shift_issue(Ub + UR + 1152 + dir * 64 + 8 * g4, t, sw, lw0);
    shift_issue(Ub + UR + 1152 + dir * 64 + 32 + 8 * g4, t, sw, lw1);
    shift_issue(Ub + UR + 1280 + dir * 64 + 8 * g4, t, sw, la0);
    shift_issue(Ub + UR + 1280 + dir * 64 + 32 + 8 * g4, t, sw, la1);
    __builtin_amdgcn_sched_barrier(0);
    {
      float blk[8];
      shift_finish(lw0, sw, PRM + 192 + 8 * g4, blk);
#pragma unroll
      for (int j = 0; j < 8; ++j) awl[0][j] = (short)f2bf(1.f - 2.f * __builtin_amdgcn_rcpf(1.f + __expf(2.f * blk[j])));
      __builtin_amdgcn_sched_barrier(0);
      shift_finish(lw1, sw, PRM + 192 + 32 + 8 * g4, blk);
#pragma unroll
      for (int j = 0; j < 8; ++j) awl[1][j] = (short)f2bf(1.f - 2.f * __builtin_amdgcn_rcpf(1.f + __expf(2.f * blk[j])));
      __builtin_amdgcn_sched_barrier(0);
      shift_finish(la0, sw, PRM + 256 + 8 * g4, blk);
#pragma unroll
      for (int j = 0; j < 8; ++j) aal[0][j] = (short)f2bf(blk[j]);
      __builtin_amdgcn_sched_barrier(0);
      shift_finish(la1, sw, PRM + 256 + 32 + 8 * g4, blk);
#pragma unroll
      for (int j = 0; j < 8; ++j) aal[1][j] = (short)f2bf(blk[j]);
      __builtin_amdgcn_sched_barrier(0);
    }
#pragma unroll
    for (int nt = 0; nt < 4; ++nt) {
      f32x4 aw = {0.f, 0.f, 0.f, 0.f}, aa = {0.f, 0.f, 0.f, 0.f};
#pragma unroll
      for (int ks = 0; ks < 2; ++ks) {
        aw = __builtin_amdgcn_mfma_f32_16x16x32_bf16(awl[ks], wf[(nt * 2 + ks) * 64], aw, 0, 0, 0);
        aa = __builtin_amdgcn_mfma_f32_16x16x32_bf16(aal[ks], wf[(8 + nt * 2 + ks) * 64], aa, 0, 0, 0);
      }
      const int col = nt * 16 + slot;
      const float w0v = PRM[576 + col];
      const float a0v = PRM[640 + col];
#pragma unroll
      for (int i = 0; i < 4; ++i) {
        const int tt = 4 * g4 + i;
        LW[tt * RS + col] = __expf(-0.6065306597126334f * sigm(w0v + aw[i]));
        LB[tt * RS + col] = sigm(a0v + aa[i]);
      }
    }
  }
  {
    const int t = t0 + tl;
    float kr[16], kap[16];
    const ShW sw = shift_weights(t, T, path);
    Sh5 lk0, lk1;
    shift_issue(Ub + UR + 384 + h * 64 + c0, t, sw, lk0);
    shift_issue(Ub + UR + 384 + h * 64 + c0 + 8, t, sw, lk1);
    shift_finish(lk0, sw, PRM + 64 + c0, kr);
    shift_finish(lk1, sw, PRM + 64 + c0 + 8, kr + 8);
    float ss = 0.f;
#pragma unroll
    for (int j = 0; j < 16; ++j) { kap[j] = kr[j] * PRM[384 + c0 + j]; ss += kap[j] * kap[j]; }
    ss += shx<1>(ss);
    ss += shx<2>(ss);
    const float inv = 1.f / fmaxf(sqrtf(ss), 1e-12f);
#pragma unroll
    for (int j4 = 0; j4 < 4; ++j4) {
      const f4v a4 = *(const f4v*)(LB + tl * RS + c0 + 4 * j4);
      f4v kh4, kt4, b4;
#pragma unroll
      for (int e = 0; e < 4; ++e) {
        const int j = 4 * j4 + e;
        const float kh = kap[j] * inv;
        kh4[e] = kh;
        kt4[e] = kr[j] * (1.f + (a4[e] - 1.f) * PRM[448 + c0 + j]);
        b4[e] = kh * a4[e];
      }
      *(f4v*)(LKH + tl * RS + c0 + 4 * j4) = kh4;
      *(f4v*)(LKT + tl * RS + c0 + 4 * j4) = kt4;
      *(f4v*)(LB + tl * RS + c0 + 4 * j4) = b4;
    }
  }
}

__device__ void rwkv_job(const Params& p, int l, int path, int unit, int wv) {
  float* smem = SMEM;
  const int tid = opaque_tid(wv);
  const int wave = wv, lane = tid & 63;
  const int b = unit / 6, h = unit % 6;
  const int T = path ? 2048 : 256, NT = T >> 4;
  if (wave == 4 || wave == 5) {
#pragma unroll 1
    for (int i = 0; i < NT + 2; ++i) __syncthreads();
    return;
  }
  const int dir = wave & 1;
  const size_t tok0 = path ? (size_t)NTP + (size_t)b * 2048 : (size_t)b * 256;
  const bfu* Ub = p.U + tok0 * UC;
  float* D = smem + dir * (2 * RBUF + 1408);
  float* PRM = D + 2 * RBUF + (wave >= 6 ? 704 : 0);
  if (wave < 2) {
    f2v S[32];
    if (path) {
      const float* sp = p.sR + ((((size_t)(b * 2 + l) * 2 + dir) * 6 + h) * 64 + lane) * 64;
#pragma unroll
      for (int k4 = 0; k4 < 16; ++k4) {
        f4v v = ((const f4v*)sp)[k4];
        S[2 * k4] = v.xy; S[2 * k4 + 1] = v.zw;
      }
    } else {
#pragma unroll
      for (int k = 0; k < 32; ++k) S[k] = (f2v){0.f, 0.f};
    }
    __syncthreads();
#pragma unroll 1
    for (int it = 0; it <= NT; ++it) {
      if (it < NT) {
        float* buf = D + (it & 1) * RBUF;
        float *LR = buf, *LV = buf + 16 * RS;
        f4v A[8], B[8];
#define LD_H(dst, s_, hf_)                                                               \
  {                                                                                      \
    const f4v* q = (const f4v*)(buf + 32 * RS + (s_) * RS) + 8 * (hf_);                  \
    _Pragma("unroll") for (int i = 0; i < 8; ++i) dst[i] = q[i];                         \
  }
#define LD_K(dst, s_, g_)                                                                \
  {                                                                                      \
    const f4v* qw = (const f4v*)(buf + 48 * RS + (s_) * RS) + 2 * (g_);                  \
    const f4v* qb = (const f4v*)(buf + 64 * RS + (s_) * RS) + 2 * (g_);                  \
    const f4v* qk = (const f4v*)(buf + 80 * RS + (s_) * RS) + 2 * (g_);                  \
    const f4v* qr = (const f4v*)(buf + (s_) * RS) + 2 * (g_);                            \
    _Pragma("unroll") for (int i = 0; i < 2; ++i) {                                      \
      dst[4 * i] = qw[i]; dst[4 * i + 1] = qb[i]; dst[4 * i + 2] = qk[i]; dst[4 * i + 3] = qr[i]; \
    }                                                                                    \
  }
#define CP_H(src, hf_)                                                                   \
  {                                                                                      \
    _Pragma("unroll") for (int i = 0; i < 8; ++i) {                                      \
      ska = __builtin_elementwise_fma(S[2 * (8 * (hf_) + i)], src[i].xy, ska);           \
      skb = __builtin_elementwise_fma(S[2 * (8 * (hf_) + i) + 1], src[i].zw, skb);       \
    }                                                                                    \
  }
#define CP_K(src, g_)                                                                    \
  {                                                                                      \
    _Pragma("unroll") for (int i = 0; i < 2; ++i) {                                      \
      const int k4 = 2 * (g_) + i;                                                       \
      f2v t0 = vv2 * src[4 * i + 2].xy, t1 = vv2 * src[4 * i + 2].zw;                    \
      t0 = __builtin_elementwise_fma(nsk2, src[4 * i + 1].xy, t0);                       \
      t1 = __builtin_elementwise_fma(nsk2, src[4 * i + 1].zw, t1);                       \
      S[2 * k4] = __builtin_elementwise_fma(S[2 * k4], src[4 * i].xy, t0);               \
      S[2 * k4 + 1] = __builtin_elementwise_fma(S[2 * k4 + 1], src[4 * i].zw, t1);       \
      ya = __builtin_elementwise_fma(S[2 * k4], src[4 * i + 3].xy, ya);                  \
      yb = __builtin_elementwise_fma(S[2 * k4 + 1], src[4 * i + 3].zw, yb);              \
    }                                                                                    \
  }
#define SB() __builtin_amdgcn_sched_barrier(0)
        const int s0 = dir ? 15 : 0, ds = dir ? -1 : 1;
        LD_H(A, s0, 0)
        SB();
#pragma unroll 1
        for (int s_ = 0; s_ < 16; ++s_) {
          const int s = s0 + ds * s_;
          const int sn = (s_ < 15) ? s + ds : s;
          f2v ska = {0.f, 0.f}, skb = {0.f, 0.f}, ya = {0.f, 0.f}, yb = {0.f, 0.f};
          const float vv = LV[s * RS + lane];
          const f2v vv2 = {vv, vv};
          LD_H(B, s, 1) SB(); CP_H(A, 0) SB();
          LD_K(A, s, 0) SB(); CP_H(B, 1) SB();
          const float sk = (ska.x + ska.y) + (skb.x + skb.y);
          const f2v nsk2 = {-sk, -sk};
          LD_K(B, s, 1) SB(); CP_K(A, 0) SB();
          LD_K(A, s, 2) SB(); CP_K(B, 1) SB();
          LD_K(B, s, 3) SB(); CP_K(A, 2) SB();
          LD_K(A, s, 4) SB(); CP_K(B, 3) SB();
          LD_K(B, s, 5) SB(); CP_K(A, 4) SB();
          LD_K(A, s, 6) SB(); CP_K(B, 5) SB();
          LD_K(B, s, 7) SB(); CP_K(A, 6) SB();
          LD_H(A, sn, 0) SB(); CP_K(B, 7) SB();
          LR[s * RS + lane] = (ya.x + ya.y) + (yb.x + yb.y);
        }
#undef LD_H
#undef LD_K
#undef CP_H
#undef CP_K
#undef SB
      }
      __syncthreads();
    }
    if (path == 0) {
      float* op = p.out + OUT_R + ((((size_t)(b * 2 + l) * 2 + dir) * 6 + h) * 64 + lane) * 64;
#pragma unroll
      for (int k4 = 0; k4 < 16; ++k4) {
        f4v v;
        v.xy = S[2 * k4]; v.zw = S[2 * k4 + 1];
        ((f4v*)op)[k4] = v;
      }
    }
  } else {
    bfu* Mb = p.HM + tok0 * DM + 384 + h * 64;
    {
      const float* mu0 = p.r_mu + l * 1408;
      PRM[lane] = mu0[h * 64 + lane];
      PRM[64 + lane] = mu0[384 + h * 64 + lane];
      PRM[128 + lane] = mu0[768 + h * 64 + lane];
      PRM[192 + lane] = mu0[1152 + dir * 64 + lane];
      PRM[256 + lane] = mu0[1280 + dir * 64 + lane];
      PRM[320 + lane] = p.r_rk[l * 384 + h * 64 + lane];
      PRM[384 + lane] = p.r_kk[l * 384 + h * 64 + lane];
      PRM[448 + lane] = p.r_ka[l * 384 + h * 64 + lane];
      PRM[512 + lane] = p.r_norm[l * 384 + h * 64 + lane];
      PRM[576 + lane] = p.r_w0[(l * 2 + dir) * 384 + h * 64 + lane];
      PRM[640 + lane] = p.r_a0[(l * 2 + dir) * 384 + h * 64 + lane];
    }
    if (wave < 4) {
      rwkv_prepA_iter(Ub, Mb, PRM, D, D, false, false, 0, true, (dir ? NT - 1 : 0) * 16, T, path, h, lane);
      __syncthreads();
#pragma unroll 1
      for (int it = 0; it <= NT; ++it) {
        const int kf = it - 1, kp = it + 1;
        rwkv_prepA_iter(Ub, Mb, PRM, D + (kf & 1) * RBUF, D + (kp & 1) * RBUF, it >= 1, kf < NT / 2, (dir ? NT - 1 - kf : kf) * 16,
                        kp < NT, (dir ? NT - 1 - kp : kp) * 16, T, path, h, lane);
        __syncthreads();
      }
    } else {
      const bf16x8* wf = (const bf16x8*)p.WF + ((size_t)((l * 2 + dir) * 6 + h) * 16) * 64 + lane;
      rwkv_prepB_tile(Ub, PRM, D, wf, (dir ? NT - 1 : 0) * 16, T, path, dir, h, lane);
      __syncthreads();
#pragma unroll 1
      for (int it = 0; it <= NT; ++it) {
        if (it + 1 < NT) {
          const int k = it + 1;
          rwkv_prepB_tile(Ub, PRM, D + (k & 1) * RBUF, wf, (dir ? NT - 1 - k : k) * 16, T, path, dir, h, lane);
        }
        __syncthreads();
      }
    }
  }
}

#define LS 72
__device__ void mlstm_job(const Params& p, int l, int path, int unit, int wv) {
  float* smem = SMEM;
  const int tid = opaque_tid(wv);
  const int wave = tid >> 6, lane = tid & 63;
  const int dir = wave >> 2, w = wave & 3, tg = tid & 255;
  const int b = unit / 6, h = unit % 6;
  const int T = path ? 2048 : 256, NC = T >> 6;
  const size_t tok0 = path ? (size_t)NTP + (size_t)b * 2048 : (size_t)b * 256;
  const bfu* Ub = p.U + tok0 * UC;
  bfu* Mb = p.HM + tok0 * DM + h * 64;
  bfu* base = (bfu*)smem + dir * (288 * LS);
  bfu *KWT = base, *VT = base + 64 * LS, *CT = base + 144 * LS, *P = base + 224 * LS;
  float* fb = smem + (2 * 288 * LS * 2) / 4 + dir * 272;
  float *X = fb, *MX = fb + 64, *BC = fb + 128, *WK = fb + 192, *SC = fb + 256;
  const int slot = lane & 15, g4 = lane >> 4;
  f32x4 C[5];
  float mstate = 0.f;
#pragma unroll
  for (int nt = 0; nt < 5; ++nt) C[nt] = (f32x4){0.f, 0.f, 0.f, 0.f};
  if (path) {
    const size_t sb = ((size_t)(b * 2 + l) * 2 + dir) * 6 + h;
    mstate = p.sm[sb];
#pragma unroll
    for (int nt = 0; nt < 4; ++nt)
#pragma unroll
      for (int i = 0; i < 4; ++i) C[nt][i] = p.sC[(sb * 64 + 16 * w + 4 * g4 + i) * 64 + nt * 16 + slot];
    if (slot == 0)
#pragma unroll
      for (int i = 0; i < 4; ++i) C[4][i] = p.sn[sb * 64 + 16 * w + 4 * g4 + i];
  }
  for (int i = tg; i < 16 * LS; i += 256) VT[64 * LS + i] = (i < 64) ? (bfu)0x3F80 : (bfu)0;
  const float bi = p.m_bi[l * 12 + dir * 6 + h], bff = p.m_bf[l * 12 + dir * 6 + h];
  __syncthreads();
  for (int ic = 0; ic < NC; ++ic) {
    const int ch = dir ? NC - 1 - ic : ic;
    const int c0t = ch * 64;
    if (w == 0) {
      const bfu* ur = Ub + (size_t)(c0t + lane) * UC;
      const float ip = bf2f(ur[UM_I + dir * 6 + h]) + bi;
      const float fp = bf2f(ur[UM_F + dir * 6 + h]) + bff;
      const float lf = fminf(fp, 0.f) - log1pf(__expf(-fabsf(fp)));
      float bs = lf;
      if (dir == 0) {
#pragma unroll
        for (int o = 1; o < 64; o <<= 1) { float v = bperm(lane - o, bs); if (lane >= o) bs += v; }
      } else {
#pragma unroll
        for (int o = 1; o < 64; o <<= 1) { float v = bperm(lane + o, bs); if (lane + o < 64) bs += v; }
      }
      const float x = ip - bs;
      float pm = x;
      if (dir == 0) {
#pragma unroll
        for (int o = 1; o < 64; o <<= 1) { float v = bperm(lane - o, pm); if (lane >= o) pm = fmaxf(pm, v); }
      } else {
#pragma unroll
        for (int o = 1; o < 64; o <<= 1) { float v = bperm(lane + o, pm); if (lane + o < 64) pm = fmaxf(pm, v); }
      }
      const int last = dir ? 0 : 63;
      const float pmtot = bperm(last, pm), bL = bperm(last, bs);
      const float mref = fmaxf(mstate, pmtot);
      X[lane] = x; MX[lane] = fmaxf(mstate, pm); BC[lane] = bs; WK[lane] = __expf(x - mref);
      if (lane == 0) { SC[0] = __expf(mstate - mref); SC[1] = bL + mref; }
    }
#pragma unroll
    for (int nt = 0; nt < 5; ++nt) {
      uint2 o;
      o.x = pack2(C[nt][0], C[nt][1]);
      o.y = pack2(C[nt][2], C[nt][3]);
      *(uint2*)(CT + (nt * 16 + slot) * LS + 16 * w + 4 * g4) = o;
    }
    __syncthreads();
    {
      const int s = tg >> 2, cq = (tg & 3) * 16;
      const bfu* ur = Ub + (size_t)(c0t + s) * UC + h * 64 + cq;
      float kf[16];
      ld8(ur + UM_K, kf); ld8(ur + UM_K + 8, kf + 8);
      const float sc = 0.125f * WK[s];
      const uint4 v0 = *(const uint4*)(ur + UM_V), v1 = *(const uint4*)(ur + UM_V + 8);
      const unsigned vv[8] = {v0.x, v0.y, v0.z, v0.w, v1.x, v1.y, v1.z, v1.w};
#pragma unroll
      for (int j = 0; j < 16; ++j) {
        KWT[(cq + j) * LS + s] = f2bf(kf[j] * sc);
        VT[(cq + j) * LS + s] = (bfu)((j & 1) ? (vv[j >> 1] >> 16) : (vv[j >> 1] & 0xffffu));
      }
    }
    bf16x8 aq[2];
    {
      const bfu* qp = Ub + (size_t)(c0t + 16 * w + slot) * UC + UM_Q + h * 64 + 8 * g4;
      aq[0] = *(const bf16x8*)qp;
      aq[1] = *(const bf16x8*)(qp + 32);
      f32x4 aS[4];
#pragma unroll
      for (int nt = 0; nt < 4; ++nt) {
        const bfu* kp = Ub + (size_t)(c0t + nt * 16 + slot) * UC + UM_K + h * 64 + 8 * g4;
        bf16x8 k0 = *(const bf16x8*)kp, k1 = *(const bf16x8*)(kp + 32);
        aS[nt] = (f32x4){0.f, 0.f, 0.f, 0.f};
        aS[nt] = __builtin_amdgcn_mfma_f32_16x16x32_bf16(aq[0], k0, aS[nt], 0, 0, 0);
        aS[nt] = __builtin_amdgcn_mfma_f32_16x16x32_bf16(aq[1], k1, aS[nt], 0, 0, 0);
      }
#pragma unroll
      for (int i = 0; i < 4; ++i) {
        const int t = 16 * w + 4 * g4 + i;
        const float mxt = MX[t];
#pragma unroll
        for (int nt = 0; nt < 4; ++nt) {
          const int s = nt * 16 + slot;
          const bool keep = dir ? (s >= t) : (s <= t);
          const float pv = keep ? aS[nt][i] * 0.125f * __expf(X[s] - mxt) : 0.f;
          P[t * LS + s] = f2bf(pv);
        }
      }
    }
    __syncthreads();
    f32x4 hv[4];
    {
      bf16x8 ap[2];
      const bfu* pp = P + (16 * w + slot) * LS + 8 * g4;
      ap[0] = *(const bf16x8*)pp; ap[1] = *(const bf16x8*)(pp + 32);
      f32x4 aC[5], aP[5];
#pragma unroll
      for (int nt = 0; nt < 5; ++nt) {
        aC[nt] = (f32x4){0.f, 0.f, 0.f, 0.f};
        aP[nt] = (f32x4){0.f, 0.f, 0.f, 0.f};
#pragma unroll
        for (int ks = 0; ks < 2; ++ks) {
          bf16x8 bc = *(const bf16x8*)(CT + (nt * 16 + slot) * LS + 32 * ks + 8 * g4);
          bf16x8 bv = *(const bf16x8*)(VT + (nt * 16 + slot) * LS + 32 * ks + 8 * g4);
          aC[nt] = __builtin_amdgcn_mfma_f32_16x16x32_bf16(aq[ks], bc, aC[nt], 0, 0, 0);
          aP[nt] = __builtin_amdgcn_mfma_f32_16x16x32_bf16(ap[ks], bv, aP[nt], 0, 0, 0);
        }
      }
#pragma unroll
      for (int i = 0; i < 4; ++i) {
        const int t = 16 * w + 4 * g4 + i;
        const float mxt = MX[t];
        const float sc = __expf(mstate - mxt);
        float den = sc * aC[4][i] + aP[4][i];
        den = bperm(lane & 48, den);
        const float lower = __expf(-(BC[t] + mxt));
        const float inv = 1.f / fmaxf(fabsf(den), lower);
#pragma unroll
        for (int nt = 0; nt < 4; ++nt) hv[nt][i] = (sc * aC[nt][i] + aP[nt][i]) * inv;
      }
    }
#pragma unroll
    for (int i = 0; i < 4; ++i) {
      const int t = c0t + 16 * w + 4 * g4 + i;
      bfu* mp = Mb + (size_t)t * DM;
      if (ic < NC / 2) {
#pragma unroll
        for (int nt = 0; nt < 4; ++nt) mp[nt * 16 + slot] = f2bf(hv[nt][i]);
      } else {
        float hh[4];
        float ss = 0.f;
#pragma unroll
        for (int nt = 0; nt < 4; ++nt) { hh[nt] = hv[nt][i] + bf2f(mp[nt * 16 + slot]); ss += hh[nt] * hh[nt]; }
        ss += shx<1>(ss); ss += shx<2>(ss); ss += shx<4>(ss); ss += shx<8>(ss);
        const float rstd = rsqrtf(ss * (1.f / 64.f) + EPSF);
        const bfu* ur = Ub + (size_t)t * UC + h * 64;
#pragma unroll
        for (int nt = 0; nt < 4; ++nt) {
          const int e = nt * 16 + slot;
          const float o = bf2f(ur[UM_O + e]), z = bf2f(ur[UM_Z + e]);
          mp[e] = f2bf(hh[nt] * rstd * p.m_norm[l * 384 + h * 64 + e] * sigm(o) * siluf(z));
        }
      }
    }
    {
      const float dec = SC[0];
      bf16x8 ak[2];
      const bfu* kp = KWT + (16 * w + slot) * LS + 8 * g4;
      ak[0] = *(const bf16x8*)kp; ak[1] = *(const bf16x8*)(kp + 32);
#pragma unroll
      for (int nt = 0; nt < 5; ++nt) {
        f32x4 aD = {0.f, 0.f, 0.f, 0.f};
#pragma unroll
        for (int ks = 0; ks < 2; ++ks) {
          bf16x8 bv = *(const bf16x8*)(VT + (nt * 16 + slot) * LS + 32 * ks + 8 * g4);
          aD = __builtin_amdgcn_mfma_f32_16x16x32_bf16(ak[ks], bv, aD, 0, 0, 0);
        }
#pragma unroll
        for (int i = 0; i < 4; ++i) C[nt][i] = dec * C[nt][i] + aD[i];
      }
      mstate = SC[1];
    }
    __syncthreads();
  }
  if (path == 0) {
    const size_t sb = ((size_t)(b * 2 + l) * 2 + dir) * 6 + h;
#pragma unroll
    for (int nt = 0; nt < 4; ++nt)
#pragma unroll
      for (int i = 0; i < 4; ++i) p.out[OUT_C + (sb * 64 + 16 * w + 4 * g4 + i) * 64 + nt * 16 + slot] = C[nt][i];
    if (slot == 0)
#pragma unroll
      for (int i = 0; i < 4; ++i) p.out[OUT_N + sb * 64 + 16 * w + 4 * g4 + i] = C[4][i];
    if (tg == 0) p.out[OUT_M + sb] = mstate;
  }
}

__device__ void lru_job(const Params& p, int l, int path, int unit, int wv) {
  float* smem = SMEM;
  const int tid = opaque_tid(wv);
  const int wave = tid >> 6, lane = tid & 63;
  const int dir = wave >> 2, w = wave & 3, tg = tid & 255;
  const int b = unit >> 2, n = unit & 3;
  const int T = path ? 2048 : 256, NT = T >> 6;
  const size_t tok0 = path ? (size_t)NTP + (size_t)b * 2048 : (size_t)b * 256;
  const bfu* Ub = p.U + tok0 * UC;
  bfu* Mb = p.HM + tok0 * DM + 768 + n * 64;
  unsigned char* sb_ = (unsigned char*)smem + dir * 41984;
  bfu* XC = (bfu*)sb_;
  float* AA = (float*)(sb_ + 9216);
  float* BB = AA + 4096;
  const int slot = lane & 15, g4 = lane >> 4;
  const bf16x8* lf = (const bf16x8*)p.LF + ((size_t)((l * 2 + dir) * 4 + n) * 16) * 64 + lane;
  float hstate = 0.f;
  if (path) hstate = p.sL[((size_t)(b * 2 + l) * 2 + dir) * 256 + n * 64 + lane];
  for (int it = 0; it < NT; ++it) {
    const int ti = dir ? NT - 1 - it : it;
    const int t0 = ti * 64;
    const int tl = tg >> 2, cq = (tg & 3) * 16;
    {
      const int t = t0 + tl;
      float acc[16];
#pragma unroll
      for (int j = 0; j < 16; ++j) acc[j] = p.l_conv_b[l * 256 + n * 64 + cq + j];
#pragma unroll
      for (int tap = 0; tap < 4; ++tap) {
        const int ts = t + tap - 2;
        const float wgt = (ts >= 0 && ts < T) ? 1.f : 0.f;
        const int tc = min(max(ts, 0), T - 1);
        float xv[16];
        const bfu* ur = Ub + (size_t)tc * UC + UL + n * 64 + cq;
        ld8(ur, xv); ld8(ur + 8, xv + 8);
#pragma unroll
        for (int j = 0; j < 16; ++j) acc[j] += wgt * xv[j] * p.l_conv[(l * 4 + tap) * 256 + n * 64 + cq + j];
      }
      *(uint4*)(XC + tl * LS + cq) = pack8(acc);
      *(uint4*)(XC + tl * LS + cq + 8) = pack8(acc + 8);
    }
    __syncthreads();
    {
      bf16x8 ax[2];
      const bfu* xp = XC + (16 * w + slot) * LS + 8 * g4;
      ax[0] = *(const bf16x8*)xp; ax[1] = *(const bf16x8*)(xp + 32);
#pragma unroll
      for (int nt = 0; nt < 4; ++nt) {
        f32x4 ga = {0.f, 0.f, 0.f, 0.f}, gx = {0.f, 0.f, 0.f, 0.f};
#pragma unroll
        for (int ks = 0; ks < 2; ++ks) {
          ga = __builtin_amdgcn_mfma_f32_16x16x32_bf16(ax[ks], lf[(nt * 2 + ks) * 64], ga, 0, 0, 0);
          gx = __builtin_amdgcn_mfma_f32_16x16x32_bf16(ax[ks], lf[(8 + nt * 2 + ks) * 64], gx, 0, 0, 0);
        }
        const int o = nt * 16 + slot;
        const int chn = (l * 2 + dir) * 256 + n * 64 + o;
        const float bav = p.l_ba[chn], bxv = p.l_bx[chn];
        const float lam = p.l_lambda[chn];
        const float sp = fmaxf(-lam, 0.f) + log1pf(__expf(-fabsf(lam)));
#pragma unroll
        for (int i = 0; i < 4; ++i) {
          const int t = 16 * w + 4 * g4 + i;
          const float rg = sigm(ga[i] + bav), ig = sigm(gx[i] + bxv);
          const float la = -8.f * rg * sp;
          const float a = __expf(la);
          const float bt = sqrtf(fmaxf(-expm1f(2.f * la), 0.f)) * ig * bf2f(XC[t * LS + o]);
          AA[t * 64 + o] = a;
          BB[t * 64 + o] = bt;
        }
      }
    }
    __syncthreads();
    if (w == 0) {
#pragma unroll 4
      for (int s_ = 0; s_ < 64; ++s_) {
        const int s = dir ? 63 - s_ : s_;
        hstate = AA[s * 64 + lane] * hstate + BB[s * 64 + lane];
        BB[s * 64 + lane] = hstate;
      }
    }
    __syncthreads();
    {
      const int t = t0 + tl;
      bfu* mp = Mb + (size_t)t * DM + cq;
      float y[16];
#pragma unroll
      for (int j = 0; j < 16; ++j) y[j] = BB[tl * 64 + cq + j];
      if (it >= NT / 2) {
        float pp[16], gz[16];
        ld8(mp, pp); ld8(mp + 8, pp + 8);
        const bfu* gp = Ub + (size_t)t * UC + ULZ + n * 64 + cq;
        ld8(gp, gz); ld8(gp + 8, gz + 8);
#pragma unroll
        for (int j = 0; j < 16; ++j) y[j] = (y[j] + pp[j]) * siluf(gz[j]);
      }
      *(uint4*)mp = pack8(y);
      *(uint4*)(mp + 8) = pack8(y + 8);
    }
    __syncthreads();
  }
  if (path == 0 && w == 0) p.out[OUT_L + ((size_t)(b * 2 + l) * 2 + dir) * 256 + n * 64 + lane] = hstate;
}

__device__ void phase_mix(const Params& p, int l, int wv) {
  __shared__ int sjob;
  for (;;) {
    if (wv == 0 && opaque_tid(0) == 0) sjob = (int)atomicAdd(&p.ctr[l], 1u);
    __syncthreads();
    const int job = __builtin_amdgcn_readfirstlane(sjob);
    __syncthreads();
    if (job >= 640) break;
    int type, path, idx;
    if (job < 48) { type = 0; path = 1; idx = job; }
    else if (job < 96) { type = 1; path = 1; idx = job - 48; }
    else if (job < 128) { type = 2; path = 1; idx = job - 96; }
    else if (job < 320) { type = 0; path = 0; idx = job - 128; }
    else if (job < 512) { type = 1; path = 0; idx = job - 320; }
    else { type = 2; path = 0; idx = job - 512; }
    if (type == 0) { if (PHM & 16) rwkv_job(p, l, path, idx, wv); }
    else if (type == 1) { if (PHM & 32) mlstm_job(p, l, path, idx, wv); }
    else { if (PHM & 64) lru_job(p, l, path, idx, wv); }
    __syncthreads();
    if (PROBE_SEL && wv == 0 && opaque_tid(0) == 0) {
      const int cat = job < 48 ? 0 : job < 96 ? 2 : job < 128 ? 3 : job < 320 ? 1 : job < 512 ? 4 : 5;
      atomicMax(&p.ts[16 + l * 8 + cat], (unsigned long long)wall_clock64());
    }
  }
}

template <bool USE_GRID>
__global__ void __launch_bounds__(NTHREADS) mega_kernel(Params p) {
  const int wv = __builtin_amdgcn_readfirstlane((int)(threadIdx.x >> 6));
  const int lo = (int)p.ph_lo, hi = (int)p.ph_hi;
  for (int ph = lo; ph < hi; ++ph) {
    if (ph == 0) { if (PHM & 1) phase_mod(p, wv); }
    else if (ph == 1) { if (PHM & 2) phase_h0(p, wv); }
    else {
      const int l = (ph - 2) / 3, s = (ph - 2) % 3;
      if (s == 0) { if (PHM & 4) phase_inproj(p, l, wv); }
      else if (s == 1) phase_mix(p, l, wv);
      else { if (PHM & 8) phase_outproj(p, l, wv); }
    }
    if constexpr (USE_GRID) {
      if (ph + 1 < hi || PROBE_SEL) cg::this_grid().sync();
    }
    if (PROBE_SEL && blockIdx.x == 0 && wv == 0 && opaque_tid(0) == 0) p.ts[ph + 1] = wall_clock64();

  }
  if (PROBE_SEL && blockIdx.x == 0 && wv == 0 && opaque_tid(0) == 0) {
    const unsigned long long tend = wall_clock64();
    unsigned long long d = 0;
    if (PROBE_SEL == 1) d = p.ts[2] - p.ts[1];
    else if (PROBE_SEL == 2) d = p.ts[3] - p.ts[2];
    else if (PROBE_SEL == 3) d = p.ts[4] - p.ts[3];
    else if (PROBE_SEL == 4) d = p.ts[5] - p.ts[4];
    else if (PROBE_SEL >= 5 && PROBE_SEL <= 10) d = p.ts[16 + PROBE_SEL - 5] - p.ts[3];
    else if (PROBE_SEL == 11) d = p.ts[8] - p.ts[7];
    while ((unsigned long long)wall_clock64() - tend < PROBE_MULT * d) asm volatile("s_sleep 2");
  }
}

extern "C" void kernel_launch(void* const* d_in, const int* in_sizes, int n_in, void* d_out, int out_size, void* d_ws,
                              size_t ws_size, hipStream_t stream) {
  static int grid = 0;
  if (grid == 0) {
    if (n_in != 34 || ws_size < WS_END) {
      fprintf(stderr, "kernel_launch: unexpected n_in %d or ws_size %zu (< %llu)\n", n_in, ws_size, WS_END);
      grid = -1;
      return;
    }
    int dev = 0, cus = 0, per_cu = 0;
    hipGetDevice(&dev);
    hipDeviceGetAttribute(&cus, hipDeviceAttributeMultiprocessorCount, dev);
#if COOP
    hipFuncSetAttribute((const void*)mega_kernel<true>, hipFuncAttributeMaxDynamicSharedMemorySize, LDS_BYTES);
    hipOccupancyMaxActiveBlocksPerMultiprocessor(&per_cu, (const void*)mega_kernel<true>, NTHREADS, LDS_BYTES);
#else
    hipFuncSetAttribute((const void*)mega_kernel<false>, hipFuncAttributeMaxDynamicSharedMemorySize, LDS_BYTES);
    hipOccupancyMaxActiveBlocksPerMultiprocessor(&per_cu, (const void*)mega_kernel<false>, NTHREADS, LDS_BYTES);
#endif
    if (per_cu < 1) { fprintf(stderr, "kernel_launch: occupancy query returned %d\n", per_cu); per_cu = 1; }
    if (per_cu > 1) per_cu = 1;
    grid = cus * per_cu;
  }
  if (grid < 0) return;
  Params p{};
  const float** pf = (const float**)&p;
  for (int i = 0; i < 34; ++i) pf[i] = (const float*)d_in[i];
  p.out = (float*)d_out;
  p.U = (bfu*)((char*)d_ws + WS_U);
  p.HM = (bfu*)((char*)d_ws + WS_HM);
  p.MOD = (float*)((char*)d_ws + WS_MOD);
  p.ctr = (unsigned int*)((char*)d_ws + WS_CTR);
  p.WF = (bfu*)((char*)d_ws + WS_WF);
  p.LF = (bfu*)((char*)d_ws + WS_LF);
  p.ts = (unsigned long long*)((char*)d_ws + WS_TS);
#if COOP
  p.ph_lo = 0; p.ph_hi = 8;
  void* args[] = {&p};
  hipError_t e = hipLaunchCooperativeKernel((const void*)mega_kernel<true>, dim3(grid), dim3(NTHREADS), args, LDS_BYTES, stream);
  if (e != hipSuccess) fprintf(stderr, "cooperative launch failed: %s (grid %d)\n", hipGetErrorString(e), grid);
#else
  for (int ph = 0; ph < 8; ++ph) {
    p.ph_lo = ph; p.ph_hi = ph + 1;
    hipLaunchKernelGGL(mega_kernel<false>, dim3(grid), dim3(NTHREADS), LDS_BYTES, stream, p);
  }
#endif
}
```
